# Optimizing an MI355X kernel written in HIP

```python
import jax
import jax.numpy as jnp
from jax import lax
import numpy as np

D_MODEL = 1024
BATCH = 4
SEQ = 4096
DEPTH = 4

HEAD_DIM = 64
RWKV_WIDTH = D_MODEL // 4
RWKV_HEADS = RWKV_WIDTH // HEAD_DIM
RWKV_DECAY_LORA = 64
RWKV_ICLR_LORA = 64
RWKV_GATE_LORA = 128
RWKV_COLS = 3 * RWKV_WIDTH + RWKV_GATE_LORA + 2 * RWKV_DECAY_LORA + 2 * RWKV_ICLR_LORA
MLA_V = 64
MLA_WIDTH = D_MODEL // 2
MLA_HEADS = MLA_WIDTH // MLA_V
MLA_NOPE = 64
MLA_ROPE = 32
MLA_Q_RANK = 384
MLA_KV_RANK = 256
MLA_COLS = MLA_Q_RANK + MLA_KV_RANK + MLA_ROPE
MLA_BLOCK = 128
RET_WIDTH = D_MODEL - RWKV_WIDTH - MLA_WIDTH
RET_HEADS = RET_WIDTH // HEAD_DIM
RET_COLS = 4 * RET_WIDTH
RET_CHUNK = 128

MIX_WIDTH = RWKV_WIDTH + MLA_WIDTH + RET_WIDTH
IN_COLS = RWKV_COLS + MLA_COLS + RET_COLS
D_FF = 2816
N_MOD = 9
ROPE_BASE = 10000.0
NORM_EPS = 1e-6
RWKV_LN_EPS = 64e-5
RET_LN_EPS = 1e-5

kernel_name = 'hybrid_rwkv7_mla_retention_encoder'


def split_cols(t, sizes):
    idx = np.cumsum(sizes)[:-1].tolist()
    return jnp.split(t, idx, axis=-1)


def rms_norm(t, eps=NORM_EPS):
    tf = t.astype(jnp.float32)
    return (tf * lax.rsqrt(jnp.mean(tf * tf, axis=-1, keepdims=True) + eps)).astype(t.dtype)


def head_norm(t, eps):
    tf = t.astype(jnp.float32)
    mu = jnp.mean(tf, axis=-1, keepdims=True)
    var = jnp.mean(jnp.square(tf - mu), axis=-1, keepdims=True)
    return (tf - mu) * lax.rsqrt(var + eps)


def modulate(t, shift, scale):
    return t * (1.0 + scale[:, None, :]) + shift[:, None, :]


def swiglu(h, w_in, w_out):
    gate, up = jnp.split(h @ w_in, 2, axis=-1)
    return (jax.nn.silu(gate) * up) @ w_out


def rotary(t, positions):
    d = t.shape[-1]
    inv = ROPE_BASE ** (-jnp.arange(0, d, 2, dtype=jnp.float32) / d)
    ang = positions.astype(jnp.float32)[..., None] * inv
    ang = ang.reshape(ang.shape[:2] + (1,) * (t.ndim - 3) + ang.shape[-1:])
    cos, sin = jnp.cos(ang).astype(t.dtype), jnp.sin(ang).astype(t.dtype)
    t1, t2 = t[..., : d // 2], t[..., d // 2:]
    return jnp.concatenate([t1 * cos - t2 * sin, t2 * cos + t1 * sin], axis=-1)


def centred_shift(t, mu):
    prev = jnp.pad(t[:, :-1], ((0, 0), (1, 0), (0, 0)))
    nxt = jnp.pad(t[:, 1:], ((0, 0), (0, 1), (0, 0)))
    return t + mu * (0.5 * (prev + nxt) - t)


def _dir_stack(t):
    t = jnp.stack([t[:, :, 0], jnp.flip(t[:, :, 1], axis=1)], axis=2)
    return jnp.transpose(t, (1, 2, 0, 3, 4))


def rwkv7_mixer(z, mu, w0, w_up, a0, a_up, g_up, k_k, k_a, r_k, ln_g, ln_b):
    B, S, _ = z.shape
    H, N = RWKV_HEADS, HEAD_DIM
    z = centred_shift(z, mu)
    r, k, v, g_lo, w_lo, a_lo = split_cols(
        z, [RWKV_WIDTH, RWKV_WIDTH, RWKV_WIDTH, RWKV_GATE_LORA, 2 * RWKV_DECAY_LORA, 2 * RWKV_ICLR_LORA])
    w_lo = w_lo.reshape(B, S, 2, RWKV_DECAY_LORA)
    a_lo = a_lo.reshape(B, S, 2, RWKV_ICLR_LORA)
    w_raw = (w0 + jnp.einsum('bsdr,drc->bsdc', jnp.tanh(w_lo), w_up)).astype(jnp.float32)
    decay = jnp.exp(-jnp.exp(-jax.nn.softplus(-w_raw) - 0.5)).reshape(B, S, 2, H, N)
    a = jax.nn.sigmoid(a0 + jnp.einsum('bsdr,drc->bsdc', a_lo, a_up))
    g = jax.nn.sigmoid(g_lo) @ g_up
    kk = (k * k_k).reshape(B, S, H, N).astype(jnp.float32)
    kk = kk / jnp.maximum(jnp.linalg.norm(kk, axis=-1, keepdims=True), 1e-12)
    kk2 = jnp.broadcast_to(kk[:, :, None], (B, S, 2, H, N))
    a5 = a.reshape(B, S, 2, H, N)
    k_mod = (k[:, :, None, :] * (1.0 + (a - 1.0) * k_a)).reshape(B, S, 2, H, N)
    rh, kh, vh = (t.reshape(B, S, H, N) for t in (r, k, v))
    r2 = jnp.broadcast_to(rh[:, :, None], (B, S, 2, H, N))
    v2 = jnp.broadcast_to(vh[:, :, None], (B, S, 2, H, N))
    xs = tuple(_dir_stack(t) for t in (decay, kk2, kk2 * a5, k_mod, v2, r2))

    def step(state, inp):
        w_t, kk_t, kka_t, k_t, v_t, r_t = inp
        sk = jnp.einsum('dbhvk,dbhk->dbhv', state, kk_t)
        new = (state * w_t[..., None, :] - sk[..., :, None] * kka_t[..., None, :]
               + v_t[..., :, None] * k_t[..., None, :])
        y_fwd = jnp.einsum('bhvk,bhk->bhv', new[0], r_t[0])
        y_bwd = jnp.einsum('bhvk,bhk->bhv', state[1], r_t[1])
        return new, jnp.stack([y_fwd, y_bwd])

    state0 = jnp.zeros((2, B, H, N, N), jnp.float32)
    _, ys = lax.scan(step, state0, xs)
    y = ys[:, 0] + jnp.flip(ys[:, 1], axis=0)
    y = jnp.transpose(y, (1, 0, 2, 3))
    y = (head_norm(y, RWKV_LN_EPS) * ln_g + ln_b).astype(z.dtype)
    bonus = jnp.sum(rh * kh * r_k, axis=-1, keepdims=True) * vh
    return (y + bonus).reshape(B, S, RWKV_WIDTH) * g


def mla_mixer(z, positions, q_norm_g, w_uq, kv_norm_g, w_ukv):
    B, S, _ = z.shape
    H = MLA_HEADS
    cq, ckv, kpe = split_cols(z, [MLA_Q_RANK, MLA_KV_RANK, MLA_ROPE])
    q = ((rms_norm(cq) * q_norm_g) @ w_uq).reshape(B, S, H, MLA_NOPE + MLA_ROPE)
    kv = ((rms_norm(ckv) * kv_norm_g) @ w_ukv).reshape(B, S, H, MLA_NOPE + MLA_V)
    q_nope, q_pe = q[..., :MLA_NOPE], rotary(q[..., MLA_NOPE:], positions)
    k_nope, v = kv[..., :MLA_NOPE], kv[..., MLA_NOPE:]
    k_pe = rotary(kpe, positions)
    scale = (MLA_NOPE + MLA_ROPE) ** -0.5
    nb = S // MLA_BLOCK
    qn_b = jnp.transpose(q_nope.reshape(B, nb, MLA_BLOCK, H, MLA_NOPE), (1, 0, 2, 3, 4))
    qp_b = jnp.transpose(q_pe.reshape(B, nb, MLA_BLOCK, H, MLA_ROPE), (1, 0, 2, 3, 4))

    def attend(blk):
        qn, qp = blk
        s = (jnp.einsum('bqhd,bkhd->bhqk', qn, k_nope)
             + jnp.einsum('bqhr,bkr->bhqk', qp, k_pe))
        p = jax.nn.softmax(s.astype(jnp.float32) * scale, axis=-1).astype(v.dtype)
        return jnp.einsum('bhqk,bkhd->bqhd', p, v)

    o = lax.map(attend, (qn_b, qp_b))
    return jnp.transpose(o, (1, 0, 2, 3, 4)).reshape(B, S, MLA_WIDTH)


def retention_dir(q, k, v, log_gamma, strict):
    B, H, S, d = q.shape
    C = RET_CHUNK
    n = S // C
    qc, kc, vc = (t.reshape(B, H, n, C, d) for t in (q, k, v))
    lg = log_gamma.astype(jnp.float32)
    pos = jnp.arange(C, dtype=jnp.float32)
    diff = pos[:, None] - pos[None, :]
    mask = diff > 0 if strict else diff >= 0
    dmat = jnp.where(mask, jnp.exp(lg[:, None, None] * jnp.maximum(diff, 0.0)), 0.0)
    scores = jnp.einsum('bhncd,bhnmd->bhncm', qc, kc) * dmat[None, :, None]
    inner = jnp.einsum('bhncm,bhnme->bhnce', scores, vc)
    k_w = kc * jnp.exp(lg[:, None] * (C - 1.0 - pos)[None, :])[None, :, None, :, None]
    kv = jnp.einsum('bhncd,bhnce->nbhde', k_w, vc)
    chunk_decay = jnp.exp(lg * C)[None, :, None, None]

    def step(R, kv_n):
        return R * chunk_decay + kv_n, R

    _, r_prev = lax.scan(step, jnp.zeros((B, H, d, d), jnp.float32), kv)
    q_w = qc * jnp.exp(lg[:, None] * (pos + 1.0)[None, :])[None, :, None, :, None]
    cross = jnp.einsum('bhncd,nbhde->bhnce', q_w, r_prev)
    return (inner + cross).reshape(B, H, S, d)


def retention_mixer(z, positions, log_rate, gn_g):
    B, S, _ = z.shape
    H, d = RET_HEADS, HEAD_DIM
    q, k, v, gate = split_cols(z, [RET_WIDTH] * 4)
    q = rotary(q.reshape(B, S, H, d), positions)
    k = rotary(k.reshape(B, S, H, d), positions) * (d ** -0.5)
    v = v.reshape(B, S, H, d)
    q, k, v = (jnp.transpose(t, (0, 2, 1, 3)) for t in (q, k, v))
    log_gamma = -jnp.exp(log_rate.astype(jnp.float32))
    y_f = retention_dir(q, k, v, log_gamma[0], False)
    y_b = jnp.flip(retention_dir(jnp.flip(q, 2), jnp.flip(k, 2), jnp.flip(v, 2), log_gamma[1], True), 2)
    y = jnp.transpose(y_f + y_b, (0, 2, 1, 3))
    y = (head_norm(y, RET_LN_EPS) * gn_g).astype(z.dtype).reshape(B, S, RET_WIDTH)
    return jax.nn.silu(gate) * y


def setup_inputs(seed: int = 0) -> dict:
    key = jax.random.key(seed)
    ks = jax.random.split(key, 32)
    L, D = DEPTH, D_MODEL
    C = RWKV_WIDTH

    def nrm(k, shape, scale):
        return jax.random.normal(k, shape, jnp.float32) * scale

    ret_base = jnp.log(2.0 ** (-5.0 - jnp.arange(RET_HEADS, dtype=jnp.float32)))
    return {
        'x': nrm(ks[0], (BATCH, SEQ, D), 1.0),
        'c': nrm(ks[1], (BATCH, D), 1.0),
        'positions': jnp.tile(jnp.arange(SEQ, dtype=jnp.int32)[None, :], (BATCH, 1)),
        'w_ada': nrm(ks[2], (L, D, N_MOD * D), 0.5 * D ** -0.5),
        'b_ada': nrm(ks[3], (L, N_MOD * D), 0.02),
        'w_ff1_in': nrm(ks[4], (L, D, 2 * D_FF), D ** -0.5),
        'w_ff1_out': nrm(ks[5], (L, D_FF, D), D_FF ** -0.5),
        'w_ff2_in': nrm(ks[6], (L, D, 2 * D_FF), D ** -0.5),
        'w_ff2_out': nrm(ks[7], (L, D_FF, D), D_FF ** -0.5),
        'w_in': nrm(ks[8], (L, D, IN_COLS), D ** -0.5),
        'w_out': nrm(ks[9], (L, MIX_WIDTH, D), MIX_WIDTH ** -0.5),
        'rwkv_mu': jax.random.uniform(ks[10], (L, RWKV_COLS), jnp.float32),
        'rwkv_w0': jax.random.uniform(ks[11], (L, 2, C), jnp.float32, minval=-5.0, maxval=1.0),
        'rwkv_w_up': nrm(ks[12], (L, 2, RWKV_DECAY_LORA, C), 0.5 * RWKV_DECAY_LORA ** -0.5),
        'rwkv_a0': nrm(ks[13], (L, 2, C), 0.5),
        'rwkv_a_up': nrm(ks[14], (L, 2, RWKV_ICLR_LORA, C), 0.5 * RWKV_ICLR_LORA ** -0.5),
        'rwkv_g_up': nrm(ks[15], (L, RWKV_GATE_LORA, C), RWKV_GATE_LORA ** -0.5),
        'rwkv_k_k': 0.85 + nrm(ks[16], (L, C), 0.05),
        'rwkv_k_a': 1.0 + nrm(ks[17], (L, C), 0.05),
        'rwkv_r_k': nrm(ks[18], (L, RWKV_HEADS, HEAD_DIM), 0.1),
        'rwkv_ln_g': 1.0 + nrm(ks[19], (L, RWKV_HEADS, HEAD_DIM), 0.05),
        'rwkv_ln_b': nrm(ks[20], (L, RWKV_HEADS, HEAD_DIM), 0.02),
        'mla_q_norm_g': 1.0 + nrm(ks[21], (L, MLA_Q_RANK), 0.05),
        'mla_w_uq': nrm(ks[22], (L, MLA_Q_RANK, MLA_HEADS * (MLA_NOPE + MLA_ROPE)), MLA_Q_RANK ** -0.5),
        'mla_kv_norm_g': 1.0 + nrm(ks[23], (L, MLA_KV_RANK), 0.05),
        'mla_w_ukv': nrm(ks[24], (L, MLA_KV_RANK, MLA_HEADS * (MLA_NOPE + MLA_V)), MLA_KV_RANK ** -0.5),
        'ret_log_rate': ret_base + nrm(ks[25], (L, 2, RET_HEADS), 0.1),
        'ret_gn_g': 1.0 + nrm(ks[26], (L, RET_HEADS, HEAD_DIM), 0.05),
        'final_norm_g': 1.0 + nrm(ks[27], (D,), 0.05),
    }


def reference(x, c, positions, w_ada, b_ada, w_ff1_in, w_ff1_out, w_ff2_in, w_ff2_out,
              w_in, w_out, rwkv_mu, rwkv_w0, rwkv_w_up, rwkv_a0, rwkv_a_up, rwkv_g_up,
              rwkv_k_k, rwkv_k_a, rwkv_r_k, rwkv_ln_g, rwkv_ln_b, mla_q_norm_g, mla_w_uq,
              mla_kv_norm_g, mla_w_ukv, ret_log_rate, ret_gn_g, final_norm_g):
    cond = jax.nn.silu(c)
    for l in range(DEPTH):
        mod = cond @ w_ada[l] + b_ada[l]
        sh1, sc1, g1, sh2, sc2, g2, sh3, sc3, g3 = jnp.split(mod, N_MOD, axis=-1)
        h = modulate(rms_norm(x), sh1, sc1)
        x = x + 0.5 * g1[:, None, :] * swiglu(h, w_ff1_in[l], w_ff1_out[l])
        h = modulate(rms_norm(x), sh2, sc2)
        z = h @ w_in[l]
        z_a, z_b, z_c = split_cols(z, [RWKV_COLS, MLA_COLS, RET_COLS])
        o_a = rwkv7_mixer(z_a, rwkv_mu[l], rwkv_w0[l], rwkv_w_up[l], rwkv_a0[l], rwkv_a_up[l],
                          rwkv_g_up[l], rwkv_k_k[l], rwkv_k_a[l], rwkv_r_k[l], rwkv_ln_g[l], rwkv_ln_b[l])
        o_b = mla_mixer(z_b, positions, mla_q_norm_g[l], mla_w_uq[l], mla_kv_norm_g[l], mla_w_ukv[l])
        o_c = retention_mixer(z_c, positions, ret_log_rate[l], ret_gn_g[l])
        mixed = jnp.concatenate([o_a, o_b, o_c], axis=-1) @ w_out[l]
        x = x + g2[:, None, :] * mixed
        h = modulate(rms_norm(x), sh3, sc3)
        x = x + 0.5 * g3[:, None, :] * swiglu(h, w_ff2_in[l], w_ff2_out[l])
    return rms_norm(x) * final_norm_g
```

```cpp
#include <hip/hip_runtime.h>
#include <hip/hip_cooperative_groups.h>
#include <cstdio>
#include <cstdint>
#include <cmath>
namespace cg = cooperative_groups;
namespace pg8 {
#define PG8_LAS __attribute__((address_space(3)))
typedef unsigned short bf16_t;
typedef short bf16x8 __attribute__((ext_vector_type(8)));
typedef float f32x4 __attribute__((ext_vector_type(4)));
typedef unsigned u32x4 __attribute__((ext_vector_type(4)));
constexpr int BM = 256, BK = 64, HALF = 128, HTB = HALF * BK * 2  , STAGE_BYTES = 8 * HTB, NXCD = 8, WGM = 8;

__host__ __device__ __forceinline__ int lds_byte(int r, int c) { const int st = (r >> 4) * 2 + (c >> 5), rr = r & 15, cc = c & 31, ob = rr * 64 + cc * 2; return st * 1024 + (ob ^ (((ob >> 9) & 1) << 5)); }
__host__ __device__ __forceinline__ void stage_rc(int b, int& R, int& C) { const int st = b / 1024, sb = b % 1024, swz = sb ^ (((sb >> 9) & 1) << 5); R = (st >> 1) * 16 + swz / 64; C = (st & 1) * 32 + (swz % 64) / 2; }
__host__ __device__ __forceinline__ int perm32(int rho) { const int n = rho >> 4, i = rho & 15; return 8 * (i >> 2) + 4 * n + (i & 3); }

struct Unit { int pm, pn; };
struct Gemm { const bf16_t* A; const bf16_t* Bt; int M, N, K; };

struct StaticOrder {
    int nM, nN, nwg, G, c;
    __host__ __device__ void init(int M, int N, int G_, int c_) { nM = M / BM; nN = N / BM; nwg = nM * nN; G = G_; c = c_; }
    __host__ __device__ bool next(int i, Unit& u) const {
        const long L = (long)i * G + c; if (L >= nwg) return false;
        int wgid = (int)L; { const int q = nwg / NXCD, r = nwg % NXCD, xcd = wgid % NXCD, off = wgid / NXCD; wgid = (xcd < r ? xcd * (q + 1) : r * (q + 1) + (xcd - r) * q) + off; }
        const int nig = WGM * nN, gid = wgid / nig, fm = gid * WGM, gsz = (nM - fm) < WGM ? (nM - fm) : WGM;
        u.pm = fm + ((wgid % nig) % gsz); u.pn = (wgid % nig) / gsz; return true;
    }
    __device__ __forceinline__ void a_ready(const Unit&) const {}
    __device__ __forceinline__ void done(const Unit&) const {}
};

__device__ __forceinline__ unsigned cvt_pk_bf16(float lo, float hi) { unsigned r; asm volatile("v_cvt_pk_bf16_f32 %0, %1, %2" : "=v"(r) : "v"(lo), "v"(hi)); return r; }
typedef float f32x2 __attribute__((ext_vector_type(2)));
typedef unsigned u32x2e __attribute__((ext_vector_type(2)));
typedef __bf16 bf16x2e __attribute__((ext_vector_type(2)));
__device__ __forceinline__ unsigned pk_bf16_rne(float lo, float hi) { f32x2 v = {lo, hi}; bf16x2e b = __builtin_convertvector(v, bf16x2e); return __builtin_bit_cast(unsigned, b); }
__device__ __forceinline__ float silu_f(float x) { return x * __builtin_amdgcn_rcpf(1.0f + __expf(-x)); }
struct EpiX {
    int MODE;
    static constexpr bool PERM = false, AFTER_DRAIN = false;
    float* F; bf16_t* Hh; const float* gv; float coef; int ldo;
    __device__ __forceinline__ void operator()(const f32x4 (&acc)[2][2][4][2], const Unit& u, int wr, int wc, int fr, int fq) const {
#pragma unroll
        for (int ai = 0; ai < 2; ++ai)
#pragma unroll
            for (int m = 0; m < 4; ++m) {
                const int r = u.pm * BM + ai * HALF + wr * 64 + m * 16 + fr;
#pragma unroll
                for (int bj = 0; bj < 2; ++bj) {
                    const int cb = u.pn * BM + bj * HALF + wc * 32;
                    const f32x4 v0 = acc[ai][bj][m][0], v1 = acc[ai][bj][m][1];
                    if (MODE == 0) {
                        u32x2e w; w.x = pk_bf16_rne(silu_f(v0[0]) * v1[0], silu_f(v0[1]) * v1[1]); w.y = pk_bf16_rne(silu_f(v0[2]) * v1[2], silu_f(v0[3]) * v1[3]);
                        *(u32x2e*)(Hh + (size_t)r * ldo + (cb >> 1) + 4 * fq) = w;
                    } else if (MODE == 1) {
                        const int b = r >> 12;
#pragma unroll
                        for (int n = 0; n < 2; ++n) { const int c = cb + 16 * n + 4 * fq; const f32x4 g = *(const f32x4*)(gv + b * 9216 + c); f32x4* xp = (f32x4*)(F + (size_t)r * 1024 + c);
                            f32x4 x = *xp; x += (n == 0 ? v0 : v1) * g * coef; *xp = x; }
                    } else if (MODE == 2) {
                        if (u.pn < 8) {
                            *(f32x4*)(F + (size_t)r * 2048 + cb + 4 * fq) = v0; *(f32x4*)(F + (size_t)r * 2048 + cb + 16 + 4 * fq) = v1;
                        } else {
                            u32x2e w0, w1; w0.x = pk_bf16_rne(v0[0], v0[1]); w0.y = pk_bf16_rne(v0[2], v0[3]); w1.x = pk_bf16_rne(v1[0], v1[1]); w1.y = pk_bf16_rne(v1[2], v1[3]);
                            *(u32x2e*)(Hh + (size_t)r * 1024 + (cb - 2048) + 4 * fq) = w0; *(u32x2e*)(Hh + (size_t)r * 1024 + (cb - 2048) + 16 + 4 * fq) = w1;
                        }
                    } else if (MODE == 4 && wc >= 2) {
                        const int hh = u.pn * 2 + bj, e0 = (wc - 2) * 32 + 4 * fq, bb = r >> 12, ss = r & 4095;
                        const int ssp = (ss & ~12) | ((ss & 4) << 1) | ((ss & 8) >> 1);
                        bf16_t* vt = (bf16_t*)F + ((size_t)((bb * 8 + hh) * 64 + e0)) * 4096 + ssp;
#pragma unroll
                        for (int j = 0; j < 4; ++j) { vt[(size_t)j * 4096] = (bf16_t)(pk_bf16_rne(v0[j], 0.f) & 0xffffu); vt[(size_t)(16 + j) * 4096] = (bf16_t)(pk_bf16_rne(v1[j], 0.f) & 0xffffu); }
                    } else {
                        u32x2e w0, w1; w0.x = pk_bf16_rne(v0[0], v0[1]); w0.y = pk_bf16_rne(v0[2], v0[3]); w1.x = pk_bf16_rne(v1[0], v1[1]); w1.y = pk_bf16_rne(v1[2], v1[3]);
                        *(u32x2e*)(Hh + (size_t)r * ldo + cb + 4 * fq) = w0; *(u32x2e*)(Hh + (size_t)r * ldo + cb + 16 + 4 * fq) = w1;
                    }
                }
            }
    }
};
template <class Epi, class Sched, bool ALIGN_EPI = false, bool SP2 = false>
__device__ __forceinline__ void gemm_phase(PG8_LAS unsigned char* lds, const Gemm g, const Sched& S, const Epi& E, int tid_in) {
    int tid_l = tid_in; asm volatile("" : "+v"(tid_l));
    const int tid = tid_l, wid = __builtin_amdgcn_readfirstlane(tid >> 6), lane = tid & 63, wr = wid >> 2, wc = wid & 3, fr = lane & 15, fq = lane >> 4;
    const int K = g.K, nt = K / BK;
    unsigned voffA[2], voffB[2];
#pragma unroll
    for (int i = 0; i < 2; ++i) { int R, C; stage_rc(tid * 16 + i * 8192, R, C); const int Rb = Epi::PERM ? ((R & ~31) + perm32(R & 31)) : R;
        voffA[i] = (unsigned)(R * K + C) * 2u; voffB[i] = (unsigned)(Rb * K + C) * 2u; }
    const size_t kstep = (size_t)(BK * 2);
    const size_t hstep = (size_t)HALF * K * 2;
    const size_t tstep = 2 * hstep;
    const unsigned ldsw = (unsigned)wid * 1024u;
    const int aoff = lds_byte(wr * 64 + fr, fq * 8), boff = lds_byte(wc * 32 + fr, fq * 8);
#define PG8_SA(b, h) (((b) * 2 + (h)) * HTB)
#define PG8_SB(b, h) ((4 + (b) * 2 + (h)) * HTB)
#define PG8_STAGE(bufoff, gbase, voff) do { _Pragma("unroll") for (int _i = 0; _i < 2; ++_i) \
        __builtin_amdgcn_global_load_lds((const unsigned*)((const char*)(gbase) + (voff)[_i]), (PG8_LAS unsigned*)(lds + (bufoff) + ldsw + _i * 8192), 16, 0, 0); } while (0)
#define PG8_LDA(dst, b, h) do { _Pragma("unroll") for (int m = 0; m < 4; ++m) _Pragma("unroll") for (int k = 0; k < 2; ++k) dst[m][k] = *(const PG8_LAS bf16x8*)(lds + PG8_SA(b, h) + aoff + m * 2048 + k * 1024); } while (0)
#define PG8_LDB(dst, b, h) do { _Pragma("unroll") for (int n = 0; n < 2; ++n) _Pragma("unroll") for (int k = 0; k < 2; ++k) dst[n][k] = *(const PG8_LAS bf16x8*)(lds + PG8_SB(b, h) + boff + n * 2048 + k * 1024); } while (0)
#define PG8_MMA(ai, bj, At, Bt) do { __builtin_amdgcn_s_setprio(1); _Pragma("unroll") for (int m = 0; m < 4; ++m) _Pragma("unroll") for (int n = 0; n < 2; ++n) _Pragma("unroll") for (int k = 0; k < 2; ++k) \
        acc[ai][bj][m][n] = __builtin_amdgcn_mfma_f32_16x16x32_bf16(Bt[n][k], At[m][k], acc[ai][bj][m][n], 0, 0, 0); __builtin_amdgcn_s_setprio(0); } while (0)
#define PG8_WAIT_V(n) asm volatile("s_waitcnt vmcnt(" #n ")" ::: "memory")
#define PG8_WAIT_L(n) asm volatile("s_waitcnt lgkmcnt(" #n ")" ::: "memory")
#define PG8_BAR __builtin_amdgcn_s_barrier()
#define PG8_SCHED __builtin_amdgcn_sched_barrier(0)
    Unit cur, nxt; int ui = 0;
    if (!S.next(0, cur)) return;
    f32x4 acc[2][2][4][2];
#pragma unroll
    for (int a = 0; a < 2; ++a)
#pragma unroll
        for (int b = 0; b < 2; ++b)
#pragma unroll
            for (int m = 0; m < 4; ++m)
#pragma unroll
                for (int n = 0; n < 2; ++n) acc[a][b][m][n] = (f32x4){0.f, 0.f, 0.f, 0.f};
    bf16x8 At[4][2], B0[2][2], B1[2][2];
    const char* cA = (const char*)g.A + (size_t)cur.pm * tstep; const char* cB = (const char*)g.Bt + (size_t)cur.pn * tstep;
    S.a_ready(cur);
    if constexpr (SP2) {
        PG8_STAGE(PG8_SB(0, 0), cB, voffB); PG8_STAGE(PG8_SB(0, 1), cB + hstep, voffB); PG8_STAGE(PG8_SA(0, 0), cA, voffA); PG8_STAGE(PG8_SA(0, 1), cA + hstep, voffA);
        if (wr == 1) PG8_BAR;
        PG8_WAIT_V(2); PG8_BAR;
        PG8_STAGE(PG8_SB(1, 0), cB + kstep, voffB); PG8_STAGE(PG8_SA(1, 0), cA + kstep, voffA); PG8_STAGE(PG8_SB(1, 1), cB + hstep + kstep, voffB);
        PG8_WAIT_V(6); PG8_BAR;
    } else {
        PG8_STAGE(PG8_SB(0, 0), cB, voffB); PG8_STAGE(PG8_SA(0, 0), cA, voffA); PG8_STAGE(PG8_SB(0, 1), cB + hstep, voffB); PG8_STAGE(PG8_SA(0, 1), cA + hstep, voffA);
        if (wr == 1) PG8_BAR;
        PG8_WAIT_V(4); PG8_BAR;
        PG8_STAGE(PG8_SB(1, 0), cB + kstep, voffB); PG8_STAGE(PG8_SA(1, 0), cA + kstep, voffA); PG8_STAGE(PG8_SB(1, 1), cB + hstep + kstep, voffB);
        PG8_WAIT_V(6); PG8_BAR;
    }
    for (;;) {
        const bool has_next = S.next(ui + 1, nxt);
        const char* nA = has_next ? (const char*)g.A + (size_t)nxt.pm * tstep : cA; const char* nB = has_next ? (const char*)g.Bt + (size_t)nxt.pn * tstep : cB;
        for (int t = 0; t < nt; t += 2) {
            const bool last = (t == nt - 2);
            const char* a1 = cA + (size_t)(t + 1) * kstep;
            const char* a2 = last ? nA : cA + (size_t)(t + 2) * kstep; const char* b2 = last ? nB : cB + (size_t)(t + 2) * kstep;
            const char* a3 = a2 + kstep; const char* b3 = b2 + kstep;
            if (last && has_next) S.a_ready(nxt);
            if constexpr (SP2) {
            PG8_LDB(B0, 0, 0); PG8_LDB(B1, 0, 1); PG8_SCHED; PG8_LDA(At, 0, 0); PG8_STAGE(PG8_SA(1, 1), a1 + hstep, voffA);
            PG8_WAIT_V(8); PG8_WAIT_L(0); PG8_BAR; PG8_MMA(0, 0, At, B0); PG8_MMA(0, 1, At, B1); PG8_BAR; PG8_SCHED;
            PG8_LDA(At, 0, 1); PG8_STAGE(PG8_SB(0, 0), b2, voffB); PG8_STAGE(PG8_SB(0, 1), b2 + hstep, voffB); PG8_STAGE(PG8_SA(0, 0), a2, voffA);
            PG8_WAIT_V(8); PG8_WAIT_L(0); PG8_BAR; PG8_MMA(1, 0, At, B0); PG8_MMA(1, 1, At, B1); PG8_BAR; PG8_SCHED;
            PG8_LDB(B0, 1, 0); PG8_LDB(B1, 1, 1); PG8_SCHED; PG8_LDA(At, 1, 0); PG8_STAGE(PG8_SA(0, 1), a2 + hstep, voffA);
            PG8_WAIT_V(8); PG8_WAIT_L(0); PG8_BAR; PG8_MMA(0, 0, At, B0); PG8_MMA(0, 1, At, B1); PG8_BAR; PG8_SCHED;
            PG8_LDA(At, 1, 1); PG8_STAGE(PG8_SB(1, 0), b3, voffB); PG8_STAGE(PG8_SB(1, 1), b3 + hstep, voffB); PG8_STAGE(PG8_SA(1, 0), a3, voffA);
            PG8_WAIT_V(8); PG8_WAIT_L(0); PG8_BAR; PG8_MMA(1, 0, At, B0); PG8_MMA(1, 1, At, B1); PG8_BAR; PG8_SCHED;
            } else {
            PG8_LDB(B0, 0, 0); PG8_SCHED; PG8_LDA(At, 0, 0); PG8_STAGE(PG8_SA(1, 1), a1 + hstep, voffA);
            PG8_WAIT_L(8); PG8_BAR; PG8_WAIT_L(0); PG8_MMA(0, 0, At, B0); PG8_BAR; PG8_SCHED;
            PG8_LDB(B1, 0, 1); PG8_STAGE(PG8_SB(0, 0), b2, voffB);
            PG8_BAR; PG8_WAIT_L(0); PG8_MMA(0, 1, At, B1); PG8_BAR;
            PG8_LDA(At, 0, 1); PG8_STAGE(PG8_SA(0, 0), a2, voffA);
            PG8_BAR; PG8_WAIT_L(0); PG8_MMA(1, 0, At, B0); PG8_BAR; PG8_SCHED;
            PG8_STAGE(PG8_SB(0, 1), b2 + hstep, voffB);
            PG8_WAIT_V(6); PG8_BAR; PG8_MMA(1, 1, At, B1); PG8_BAR;
            PG8_LDB(B0, 1, 0); PG8_SCHED; PG8_LDA(At, 1, 0); PG8_STAGE(PG8_SA(0, 1), a2 + hstep, voffA);
            PG8_WAIT_L(8); PG8_BAR; PG8_WAIT_L(0); PG8_MMA(0, 0, At, B0); PG8_BAR; PG8_SCHED;
            PG8_LDB(B1, 1, 1); PG8_STAGE(PG8_SB(1, 0), b3, voffB);
            PG8_BAR; PG8_WAIT_L(0); PG8_MMA(0, 1, At, B1); PG8_BAR;
            PG8_LDA(At, 1, 1); PG8_STAGE(PG8_SA(1, 0), a3, voffA);
            PG8_BAR; PG8_WAIT_L(0); PG8_MMA(1, 0, At, B0); PG8_BAR; PG8_SCHED;
            PG8_STAGE(PG8_SB(1, 1), b3 + hstep, voffB);
            PG8_WAIT_V(6); PG8_BAR; PG8_MMA(1, 1, At, B1); PG8_BAR;
            }
        }
        if constexpr (ALIGN_EPI) { if (wr == 0) PG8_BAR; }
        if constexpr (!Epi::AFTER_DRAIN) { E(acc, cur, wr, wc, fr, fq); S.done(cur); }
        if (!has_next) break;
#pragma unroll
        for (int a = 0; a < 2; ++a)
#pragma unroll
            for (int b = 0; b < 2; ++b)
#pragma unroll
                for (int m = 0; m < 4; ++m)
#pragma unroll
                    for (int n = 0; n < 2; ++n) acc[a][b][m][n] = (f32x4){0.f, 0.f, 0.f, 0.f};
        cur = nxt; cA = nA; cB = nB; ++ui;
        if constexpr (ALIGN_EPI) { if (wr == 1) PG8_BAR; }
    }
    PG8_WAIT_V(0);
    if constexpr (!ALIGN_EPI) { if (wr == 0) PG8_BAR; }
    PG8_BAR;
    if constexpr (Epi::AFTER_DRAIN) { E.fused(acc, cur, wr, wc, fr, fq, lds, wid, lane); S.done(cur); }
#undef PG8_SA
#undef PG8_SB
#undef PG8_STAGE
#undef PG8_LDA
#undef PG8_LDB
#undef PG8_MMA
#undef PG8_WAIT_V
#undef PG8_WAIT_L
#undef PG8_BAR
#undef PG8_SCHED
}
}
namespace mk {
using pg8::bf16_t; using pg8::bf16x8; using pg8::f32x4;
typedef float f32x16 __attribute__((ext_vector_type(16)));
typedef float f32x2 __attribute__((ext_vector_type(2)));
typedef unsigned u32x4 __attribute__((ext_vector_type(4)));
typedef unsigned u32x2 __attribute__((ext_vector_type(2)));
typedef short s16x4 __attribute__((ext_vector_type(4)));

constexpr int NB = 4, S = 4096, T = NB * S, D = 1024, L = 4, FF = 2816;
constexpr size_t MiB = 1u << 20;
constexpr size_t WS_MOD = 0, WS_WBF = 1 * MiB, WS_H = 44 * MiB, WS_ZF = 76 * MiB, WS_A = 76 * MiB, WS_Y = 76 * MiB, WS_QB = 108 * MiB, WS_KVB = 132 * MiB, WS_RT = 164 * MiB,
    WS_ZR = 204 * MiB, WS_CQN = 236 * MiB, WS_CKVN = 248 * MiB, WS_KPE = 256 * MiB, WS_DEC = 257 * MiB, WS_KKA = 289 * MiB, WS_KMOD = 321 * MiB, WS_KK = 353 * MiB,
    WS_RKV = 369 * MiB, WS_G = 417 * MiB, WS_KVT = 433 * MiB, WS_END = 449 * MiB, WS_VT = 172 * MiB, WS_CTR = 819200 + 16384;
constexpr size_t WB_W1A = 0, WB_W2A = 11534336, WB_W1B = 17301504, WB_W2B = 28835840, WB_WIN = 34603008, WB_WOUT = 40894464, WB_WUQ = 42991616, WB_WUKV = 43581440, WB_LWUP = 44105728, WB_LAUP = 44105728 + 65536, WB_LGUP = 44105728 + 131072;
constexpr int LDS_BYTES = 147456;
constexpr float LOG2E = 1.4426950408889634f, LOG2_1E4 = 13.287712379549449f;

struct Params { const void* in[29]; float* out; unsigned char* ws; };
typedef __attribute__((address_space(4))) const unsigned long long* karg_ptr;
__device__ __forceinline__ const void* kin(int i) { karg_ptr ka = (karg_ptr)__builtin_amdgcn_kernarg_segment_ptr(); asm volatile("" : "+s"(ka)); return (const void*)(__attribute__((address_space(1))) const void*)ka[i]; }
__device__ __forceinline__ float* kout() { return (float*)kin(29); }
__device__ __forceinline__ unsigned char* kws() { return (unsigned char*)kin(30); }
#define LAUNDER_V(x) asm volatile("" : "+v"(x))

__device__ __forceinline__ unsigned pk2(float lo, float hi) { return pg8::pk_bf16_rne(lo, hi); }
__device__ __forceinline__ float bf2f(unsigned short u) { return __uint_as_float(((unsigned)u) << 16); }
__device__ __forceinline__ float wave_sum(float v) {
#pragma unroll
    for (int o = 1; o < 64; o <<= 1) v += __shfl_xor(v, o);
    return v;
}
__device__ __forceinline__ float half_sum(float v) {
#pragma unroll
    for (int o = 1; o < 32; o <<= 1) v += __shfl_xor(v, o);
    return v;
}
__device__ __forceinline__ int crow(int r, int hi) { return (r & 3) + 8 * (r >> 2) + 4 * hi; }
#define MFMA32(a, b, c) __builtin_amdgcn_mfma_f32_32x32x16_bf16((a), (b), (c), 0, 0, 0)
#define LDSWAIT() asm volatile("s_waitcnt lgkmcnt(0)" ::: "memory")
__device__ __forceinline__ void sincos_rr(float ang, float& s, float& c) {
    const float k = rintf(ang * 0.15915494309189535f);
    float r = fmaf(-k, 6.2831854820251465f, ang);
    r = fmaf(-k, -1.7484556e-7f, r);
    s = __sinf(r); c = __cosf(r);
}
__device__ __forceinline__ float sigmoid_f(float x) { return 1.0f / (1.0f + expf(-x)); }

__device__ __forceinline__ void phase_mod(const Params& P, unsigned char* lds, int tid) {
    float* cond = (float*)lds; float* red = cond + 4096;
    const float* c = (const float*)kin(1); const float* w_ada = (const float*)kin(3); const float* b_ada = (const float*)kin(4);
    float* mod = (float*)(kws() + WS_MOD);
    for (int i = tid; i < 4096; i += 512) { const float v = c[i]; cond[i] = v / (1.0f + expf(-v)); }
    __syncthreads();
    const int ks = tid >> 4, cq = tid & 15;
    for (int item = blockIdx.x; item < 576; item += gridDim.x) {
        const int l = item / 144, n0 = (item % 144) * 64;
        const float* W = w_ada + (size_t)l * 1024 * 9216 + (size_t)(ks * 32) * 9216 + n0 + 4 * cq;
        f32x4 a0 = {0.f, 0.f, 0.f, 0.f}, a1 = a0, a2 = a0, a3 = a0;
        f32x4 wv[32];
#pragma unroll
        for (int k = 0; k < 32; ++k) wv[k] = *(const f32x4*)(W + (size_t)k * 9216);
#pragma unroll
        for (int k = 0; k < 32; ++k) { const int kk = ks * 32 + k; a0 += wv[k] * cond[kk]; a1 += wv[k] * cond[1024 + kk]; a2 += wv[k] * cond[2048 + kk]; a3 += wv[k] * cond[3072 + kk]; }
        *(f32x4*)(red + (ks * 4 + 0) * 64 + 4 * cq) = a0; *(f32x4*)(red + (ks * 4 + 1) * 64 + 4 * cq) = a1; *(f32x4*)(red + (ks * 4 + 2) * 64 + 4 * cq) = a2; *(f32x4*)(red + (ks * 4 + 3) * 64 + 4 * cq) = a3;
        __syncthreads();
        if (tid < 256) { const int b = tid >> 6, col = tid & 63; float sum = 0.f;
#pragma unroll
            for (int q = 0; q < 32; ++q) sum += red[(q * 4 + b) * 64 + col];
            mod[(size_t)(l * 4 + b) * 9216 + n0 + col] = sum + b_ada[l * 9216 + n0 + col]; }
        __syncthreads();
    }
}

__device__ __forceinline__ int srccol(int kind, int rho) {
    if (kind == 1) { const int G = rho >> 5, w = rho & 31; return w < 16 ? 16 * G + w : 2816 + 16 * G + (w - 16); }
    if (kind == 2) { return rho < 1824 ? rho : (rho < 2048 ? -1 : rho - 224); }
    return rho;
}
__device__ __forceinline__ void tr_item(const float* W, int K, int Nsrc, int Ndst, bf16_t* WT, int kind, float* scr, int item, int lane) {
    const int nblk = Ndst / 32, kb = item / nblk, nb = item % nblk, k0 = 64 * kb, n0 = 32 * nb;
    const int sc = srccol(kind, n0 + (lane & 31));
    float tv[32];
#pragma unroll
    for (int i = 0; i < 32; ++i) { const int kk = 2 * i + (lane >> 5); tv[i] = sc >= 0 ? W[(size_t)(k0 + kk) * Nsrc + sc] : 0.f; }
#pragma unroll
    for (int i = 0; i < 32; ++i) { const int kk = 2 * i + (lane >> 5); scr[kk * 33 + (lane & 31)] = tv[i]; }
    LDSWAIT();
    const int c = lane & 7;
#pragma unroll
    for (int j = 0; j < 4; ++j) { const int n = (lane >> 3) + 8 * j; const float* s = scr + (8 * c) * 33 + n;
        u32x4 o; o.x = pk2(s[0 * 33], s[1 * 33]); o.y = pk2(s[2 * 33], s[3 * 33]); o.z = pk2(s[4 * 33], s[5 * 33]); o.w = pk2(s[6 * 33], s[7 * 33]);
        *(u32x4*)(WT + (size_t)(n0 + n) * K + k0 + 8 * c) = o; }
    LDSWAIT();
}
__device__ __forceinline__ void convert_weights(const Params& P, int l, unsigned char* lds, int gw, int NGW, int wave, int lane) {
    float* scr = (float*)(lds + wave * 16384);
    unsigned char* wb = kws() + WS_WBF;
    constexpr int I_W1 = 16 * 176, I_W2 = 44 * 32, I_IN = 16 * 96, I_OUT = 16 * 32, I_UQ = 6 * 24, I_UKV = 4 * 32;
    constexpr int I_LO = 8, I_LG = 16;
    constexpr int NIT = 2 * I_W1 + 2 * I_W2 + I_IN + I_OUT + I_UQ + I_UKV + 4 * I_LO + I_LG;
    for (int it = gw; it < NIT; it += NGW) {
        int r = it;
        if (r < I_W1) { tr_item((const float*)kin(5) + (size_t)l * 1024 * 5632, 1024, 5632, 5632, (bf16_t*)(wb + WB_W1A), 1, scr, r, lane); continue; } r -= I_W1;
        if (r < I_W2) { tr_item((const float*)kin(6) + (size_t)l * 2816 * 1024, 2816, 1024, 1024, (bf16_t*)(wb + WB_W2A), 0, scr, r, lane); continue; } r -= I_W2;
        if (r < I_W1) { tr_item((const float*)kin(7) + (size_t)l * 1024 * 5632, 1024, 5632, 5632, (bf16_t*)(wb + WB_W1B), 1, scr, r, lane); continue; } r -= I_W1;
        if (r < I_W2) { tr_item((const float*)kin(8) + (size_t)l * 2816 * 1024, 2816, 1024, 1024, (bf16_t*)(wb + WB_W2B), 0, scr, r, lane); continue; } r -= I_W2;
        if (r < I_IN) { tr_item((const float*)kin(9) + (size_t)l * 1024 * 2848, 1024, 2848, 3072, (bf16_t*)(wb + WB_WIN), 2, scr, r, lane); continue; } r -= I_IN;
        if (r < I_OUT) { tr_item((const float*)kin(10) + (size_t)l * 1024 * 1024, 1024, 1024, 1024, (bf16_t*)(wb + WB_WOUT), 0, scr, r, lane); continue; } r -= I_OUT;
        if (r < I_UQ) { tr_item((const float*)kin(23) + (size_t)l * 384 * 768, 384, 768, 768, (bf16_t*)(wb + WB_WUQ), 0, scr, r, lane); continue; } r -= I_UQ;
        if (r < I_UKV) { tr_item((const float*)kin(25) + (size_t)l * 256 * 1024, 256, 1024, 1024, (bf16_t*)(wb + WB_WUKV), 0, scr, r, lane); continue; } r -= I_UKV;
        if (r < 2 * I_LO) { const int d = r / I_LO; tr_item((const float*)kin(13) + (size_t)(l * 2 + d) * 64 * 256, 64, 256, 256, (bf16_t*)(wb + WB_LWUP) + d * 256 * 64, 0, scr, r % I_LO, lane); continue; } r -= 2 * I_LO;
        if (r < 2 * I_LO) { const int d = r / I_LO; tr_item((const float*)kin(15) + (size_t)(l * 2 + d) * 64 * 256, 64, 256, 256, (bf16_t*)(wb + WB_LAUP) + d * 256 * 64, 0, scr, r % I_LO, lane); continue; } r -= 2 * I_LO;
        tr_item((const float*)kin(16) + (size_t)l * 128 * 256, 128, 256, 256, (bf16_t*)(wb + WB_LGUP), 0, scr, r, lane);
    }
}

__device__ __forceinline__ void norm_rows(const Params& P, const float* src, float* copy_dst, int l, int shi, int gw, int NGW, int lane) {
    const float* modl = (const float*)(kws() + WS_MOD) + (size_t)l * 4 * 9216;
    bf16_t* H = (bf16_t*)(kws() + WS_H);
    for (int m0 = 2 * gw; m0 < T; m0 += 2 * NGW) {
        f32x4 v[2][4]; float s[2] = {0.f, 0.f};
#pragma unroll
        for (int q = 0; q < 2; ++q) { const f32x4* xr = (const f32x4*)(src + (size_t)(m0 + q) * D) + lane;
#pragma unroll
            for (int j = 0; j < 4; ++j) v[q][j] = xr[64 * j]; }
#pragma unroll
        for (int q = 0; q < 2; ++q) {
#pragma unroll
            for (int j = 0; j < 4; ++j) s[q] += (v[q][j].x * v[q][j].x + v[q][j].y * v[q][j].y) + (v[q][j].z * v[q][j].z + v[q][j].w * v[q][j].w); }
#pragma unroll
        for (int q = 0; q < 2; ++q) {
            const int m = m0 + q, b = m >> 12;
            const float rstd = 1.0f / sqrtf(wave_sum(s[q]) * (1.0f / D) + 1e-6f);
            const f32x4* sh = (const f32x4*)(modl + (size_t)b * 9216 + shi * 1024) + lane;
            const f32x4* sc = (const f32x4*)(modl + (size_t)b * 9216 + (shi + 1) * 1024) + lane;
            u32x2* o8 = (u32x2*)(H + (size_t)m * D) + lane;
#pragma unroll
            for (int j = 0; j < 4; ++j) { const f32x4 a = sh[64 * j], c = sc[64 * j]; const f32x4 o = v[q][j] * rstd * (c + 1.0f) + a;
                u32x2 w; w.x = pk2(o.x, o.y); w.y = pk2(o.z, o.w); o8[64 * j] = w; }
            if (copy_dst) { f32x4* cd = (f32x4*)(copy_dst + (size_t)m * D) + lane;
#pragma unroll
                for (int j = 0; j < 4; ++j) cd[64 * j] = v[q][j]; }
        }
    }
}
__device__ __forceinline__ void final_norm(const Params& P, int gw, int NGW, int lane) {
    const float* g = (const float*)kin(28);
    for (int m0 = 2 * gw; m0 < T; m0 += 2 * NGW) {
        f32x4 v[2][4]; float s[2] = {0.f, 0.f};
#pragma unroll
        for (int q = 0; q < 2; ++q) { const f32x4* xr = (const f32x4*)(kout() + (size_t)(m0 + q) * D) + lane;
#pragma unroll
            for (int j = 0; j < 4; ++j) v[q][j] = xr[64 * j]; }
#pragma unroll
        for (int q = 0; q < 2; ++q) {
#pragma unroll
            for (int j = 0; j < 4; ++j) s[q] += (v[q][j].x * v[q][j].x + v[q][j].y * v[q][j].y) + (v[q][j].z * v[q][j].z + v[q][j].w * v[q][j].w); }
#pragma unroll
        for (int q = 0; q < 2; ++q) {
            f32x4* xr = (f32x4*)(kout() + (size_t)(m0 + q) * D) + lane;
            const float rstd = 1.0f / sqrtf(wave_sum(s[q]) * (1.0f / D) + 1e-6f);
#pragma unroll
            for (int j = 0; j < 4; ++j) { const f32x4 gg = ((const f32x4*)g)[lane + 64 * j]; xr[64 * j] = v[q][j] * rstd * gg; }
        }
    }
}

constexpr int ZL = 392;
__device__ __forceinline__ void rwkv_prep(const Params& P, int l, unsigned char* lds, int tid) {
    bf16_t* zl = (bf16_t*)lds;
    float* kl = (float*)(lds + 64 * ZL * 2);
    const float* ZF = (const float*)(kws() + WS_ZF);
    float* RKV = (float*)(kws() + WS_RKV); float* DEC = (float*)(kws() + WS_DEC); float* KKA = (float*)(kws() + WS_KKA); float* KMOD = (float*)(kws() + WS_KMOD);
    float* KK = (float*)(kws() + WS_KK); float* G = (float*)(kws() + WS_G);
    const float* mu = (const float*)kin(11) + l * 1152;
    const float* w0 = (const float*)kin(12) + l * 512; const float* a0 = (const float*)kin(14) + l * 512;
    const float* k_k = (const float*)kin(17) + l * 256; const float* k_a = (const float*)kin(18) + l * 256;
    const bf16_t* WUP = (const bf16_t*)(kws() + WS_WBF + WB_LWUP); const bf16_t* AUP = (const bf16_t*)(kws() + WS_WBF + WB_LAUP); const bf16_t* GUP = (const bf16_t*)(kws() + WS_WBF + WB_LGUP);
    for (int tile = blockIdx.x; tile < T / 64; tile += gridDim.x) {
        LAUNDER_V(tid);
        const int lane = tid & 63, wid = tid >> 6, r32 = lane & 31, hi = lane >> 5, h = wid & 3, th = wid >> 2;
        const int t0 = tile * 64, s0 = t0 & (S - 1);
#pragma unroll 4
        for (int idx = tid; idx < 64 * 288; idx += 512) {
            const int row = idx / 288, c4 = idx % 288, t = t0 + row, s = s0 + row;
            const f32x4 z = *(const f32x4*)(ZF + (size_t)t * 2048 + 4 * c4);
            f32x4 pv = {0.f, 0.f, 0.f, 0.f}, nx = {0.f, 0.f, 0.f, 0.f};
            if (s > 0) pv = *(const f32x4*)(ZF + (size_t)(t - 1) * 2048 + 4 * c4);
            if (s < S - 1) nx = *(const f32x4*)(ZF + (size_t)(t + 1) * 2048 + 4 * c4);
            const f32x4 m4 = *(const f32x4*)(mu + 4 * c4);
            f32x4 v = z + m4 * ((pv + nx) * 0.5f - z);
            const int col = 4 * c4;
            if (col < 768) {
                *(f32x4*)(RKV + (size_t)t * 768 + col) = v;
                if (col >= 256 && col < 512) *(f32x4*)(kl + row * 256 + (col - 256)) = v;
            } else {
                if (col < 896) { v.x = sigmoid_f(v.x); v.y = sigmoid_f(v.y); v.z = sigmoid_f(v.z); v.w = sigmoid_f(v.w); }
                else if (col < 1024) { v.x = tanhf(v.x); v.y = tanhf(v.y); v.z = tanhf(v.z); v.w = tanhf(v.w); }
                u32x2 w; w.x = pk2(v.x, v.y); w.y = pk2(v.z, v.w);
                *(u32x2*)(zl + row * ZL + (col - 768)) = w;
            }
        }
        __syncthreads();
        const bf16_t* za = zl + (32 * th + r32) * ZL + 8 * hi;
        const int cA = h * 64 + r32;
        float kinv[16];
        const float kk_c0 = k_k[cA], kk_c1 = k_k[cA + 32];
#pragma unroll
        for (int r = 0; r < 16; ++r) { const int tok = 32 * th + crow(r, hi); const float x0 = kl[tok * 256 + cA] * kk_c0, x1 = kl[tok * 256 + cA + 32] * kk_c1;
            const float nrm = sqrtf(half_sum(x0 * x0 + x1 * x1)); kinv[r] = 1.0f / fmaxf(nrm, 1e-12f);
            const unsigned t = (unsigned)(t0 + tok); KK[t * 256 + cA] = x0 * kinv[r]; KK[t * 256 + cA + 32] = x1 * kinv[r]; __builtin_amdgcn_sched_barrier(0); }
        const float ka0 = k_a[cA], ka1 = k_a[cA + 32];
#pragma unroll 1
        for (int d = 0; d < 2; ++d) {
            int dl = d; asm volatile("" : "+s"(dl));
            int t0l = t0; asm volatile("" : "+s"(t0l));
            { f32x16 c0, c1;
#pragma unroll
              for (int i = 0; i < 16; ++i) { c0[i] = 0.f; c1[i] = 0.f; }
              const bf16_t* wt = WUP + (size_t)dl * 256 * 64;
#pragma unroll
              for (int s = 0; s < 4; ++s) { const bf16x8 a = *(const bf16x8*)(za + 128 + dl * 64 + 16 * s);
                  const bf16x8 b0 = *(const bf16x8*)(wt + (size_t)cA * 64 + 16 * s + 8 * hi), b1 = *(const bf16x8*)(wt + (size_t)(cA + 32) * 64 + 16 * s + 8 * hi);
                  c0 = MFMA32(a, b0, c0); c1 = MFMA32(a, b1, c1); }
              const float wb0 = w0[dl * 256 + cA], wb1 = w0[dl * 256 + cA + 32];
#pragma unroll
              for (int r = 0; r < 16; ++r) { const unsigned t = (unsigned)(dl * T + t0l + 32 * th + crow(r, hi));
                  DEC[t * 256 + cA] = expf(-0.6065306597126334f * sigmoid_f(wb0 + c0[r])); DEC[t * 256 + cA + 32] = expf(-0.6065306597126334f * sigmoid_f(wb1 + c1[r])); __builtin_amdgcn_sched_barrier(0); } }
            { f32x16 c0, c1;
#pragma unroll
              for (int i = 0; i < 16; ++i) { c0[i] = 0.f; c1[i] = 0.f; }
              const bf16_t* wt = AUP + (size_t)dl * 256 * 64;
#pragma unroll
              for (int s = 0; s < 4; ++s) { const bf16x8 a = *(const bf16x8*)(za + 256 + dl * 64 + 16 * s);
                  const bf16x8 b0 = *(const bf16x8*)(wt + (size_t)cA * 64 + 16 * s + 8 * hi), b1 = *(const bf16x8*)(wt + (size_t)(cA + 32) * 64 + 16 * s + 8 * hi);
                  c0 = MFMA32(a, b0, c0); c1 = MFMA32(a, b1, c1); }
              const float ab0 = a0[dl * 256 + cA], ab1 = a0[dl * 256 + cA + 32];
#pragma unroll
              for (int r = 0; r < 16; ++r) { const unsigned t = (unsigned)(dl * T + t0l + 32 * th + crow(r, hi));
                  const float ad0 = sigmoid_f(ab0 + c0[r]), ad1 = sigmoid_f(ab1 + c1[r]);
                  const int tok = 32 * th + crow(r, hi); const float kq0 = kl[tok * 256 + cA], kq1 = kl[tok * 256 + cA + 32];
                  KKA[t * 256 + cA] = -(kq0 * kk_c0 * kinv[r] * ad0); KKA[t * 256 + cA + 32] = -(kq1 * kk_c1 * kinv[r] * ad1);
                  KMOD[t * 256 + cA] = kq0 * (1.0f + (ad0 - 1.0f) * ka0); KMOD[t * 256 + cA + 32] = kq1 * (1.0f + (ad1 - 1.0f) * ka1); __builtin_amdgcn_sched_barrier(0); } }
        }
        { f32x16 c0, c1;
#pragma unroll
          for (int i = 0; i < 16; ++i) { c0[i] = 0.f; c1[i] = 0.f; }
#pragma unroll
          for (int s = 0; s < 8; ++s) { const bf16x8 a = *(const bf16x8*)(za + 16 * s);
              const bf16x8 b0 = *(const bf16x8*)(GUP + (size_t)cA * 128 + 16 * s + 8 * hi), b1 = *(const bf16x8*)(GUP + (size_t)(cA + 32) * 128 + 16 * s + 8 * hi);
              c0 = MFMA32(a, b0, c0); c1 = MFMA32(a, b1, c1); }
#pragma unroll
          for (int r = 0; r < 16; ++r) { const unsigned t = (unsigned)(t0 + 32 * th + crow(r, hi)); G[t * 256 + cA] = c0[r]; G[t * 256 + cA + 32] = c1[r]; __builtin_amdgcn_sched_barrier(0); } }
        __syncthreads();
    }
}

__device__ __forceinline__ void mla_prep(const Params& P, int l, int gw, int NGW, int lane) {
    const float* ZF = (const float*)(kws() + WS_ZF); const int* pos = (const int*)kin(2);
    bf16_t* CQN = (bf16_t*)(kws() + WS_CQN); bf16_t* CKVN = (bf16_t*)(kws() + WS_CKVN); bf16_t* KPE = (bf16_t*)(kws() + WS_KPE);
    const float* qg = (const float*)kin(22) + l * 384; const float* kg = (const float*)kin(24) + l * 256;
    for (int mm = 2 * gw; mm < T; mm += 2 * NGW) {
        float q[2][6], kv[2][4], t1[2], t2[2]; int ps[2];
#pragma unroll
        for (int u = 0; u < 2; ++u) { const float* row = ZF + (size_t)(mm + u) * 2048;
#pragma unroll
            for (int j = 0; j < 6; ++j) q[u][j] = row[1152 + lane + 64 * j];
#pragma unroll
            for (int j = 0; j < 4; ++j) kv[u][j] = row[1536 + lane + 64 * j];
            t1[u] = row[1792 + (lane & 15)]; t2[u] = row[1808 + (lane & 15)]; ps[u] = pos[mm + u]; }
#pragma unroll
        for (int u = 0; u < 2; ++u) {
            const int m = mm + u;
            float s = 0.f;
#pragma unroll
            for (int j = 0; j < 6; ++j) s += q[u][j] * q[u][j];
            float rstd = 1.0f / sqrtf(wave_sum(s) * (1.0f / 384.0f) + 1e-6f);
#pragma unroll
            for (int j = 0; j < 6; ++j) CQN[(size_t)m * 384 + lane + 64 * j] = (bf16_t)(pk2(q[u][j] * rstd * qg[lane + 64 * j], 0.f) & 0xffffu);
            s = 0.f;
#pragma unroll
            for (int j = 0; j < 4; ++j) s += kv[u][j] * kv[u][j];
            rstd = 1.0f / sqrtf(wave_sum(s) * (1.0f / 256.0f) + 1e-6f);
#pragma unroll
            for (int j = 0; j < 4; ++j) CKVN[(size_t)m * 256 + lane + 64 * j] = (bf16_t)(pk2(kv[u][j] * rstd * kg[lane + 64 * j], 0.f) & 0xffffu);
            if (lane < 16) {
                const float inv = exp2f(-(float)lane * (LOG2_1E4 / 16.0f));
                float sn, cs; sincos_rr((float)ps[u] * inv, sn, cs);
                KPE[(size_t)m * 32 + lane] = (bf16_t)(pk2(t1[u] * cs - t2[u] * sn, 0.f) & 0xffffu);
                KPE[(size_t)m * 32 + 16 + lane] = (bf16_t)(pk2(t2[u] * cs + t1[u] * sn, 0.f) & 0xffffu);
            }
        }
    }
}

constexpr int RS = 136;
__device__ __forceinline__ void ret_state(const Params& P, int l, unsigned char* lds, int tid) {
    bf16_t* Ktf = (bf16_t*)lds; bf16_t* Ktb = Ktf + 64 * RS; bf16_t* Vt = Ktb + 64 * RS;
    bf16_t* ZR = (bf16_t*)(kws() + WS_ZR); float* KVT = (float*)(kws() + WS_KVT);
    const int* pos = (const int*)kin(2); const float* lr = (const float*)kin(26) + l * 8;
    for (int u = blockIdx.x; u < 512; u += gridDim.x) {
        LAUNDER_V(tid);
        const int lane = tid & 63, wid = tid >> 6, r32 = lane & 31, hi = lane >> 5;
        const int b = u >> 7, h = (u >> 5) & 3, n = u & 31;
        const float lgf2 = -expf(lr[h]) * LOG2E, lgb2 = -expf(lr[4 + h]) * LOG2E;
        const size_t t0 = (size_t)b * S + n * 128;
        {
            const int c = tid & 127, i8 = tid >> 7;
            bf16_t* row = ZR + (t0 + c) * 1024 + h * 64;
            const u32x4 qlo = *(const u32x4*)(row + 8 * i8), qhi = *(const u32x4*)(row + 32 + 8 * i8);
            const u32x4 klo = *(const u32x4*)(row + 256 + 8 * i8), khi = *(const u32x4*)(row + 256 + 32 + 8 * i8);
            const float p = (float)pos[t0 + c];
            const float wf = exp2f(lgf2 * (float)(127 - c)), wb = exp2f(lgb2 * (float)c);
            u32x4 oql, oqh, okl, okh;
#pragma unroll
            for (int jj = 0; jj < 4; ++jj) {
                float ql[2], qh[2], kl[2], kh[2], nql[2], nqh[2], nkl[2], nkh[2];
                ql[0] = bf2f((unsigned short)(qlo[jj] & 0xffffu)); ql[1] = bf2f((unsigned short)(qlo[jj] >> 16));
                qh[0] = bf2f((unsigned short)(qhi[jj] & 0xffffu)); qh[1] = bf2f((unsigned short)(qhi[jj] >> 16));
                kl[0] = bf2f((unsigned short)(klo[jj] & 0xffffu)); kl[1] = bf2f((unsigned short)(klo[jj] >> 16));
                kh[0] = bf2f((unsigned short)(khi[jj] & 0xffffu)); kh[1] = bf2f((unsigned short)(khi[jj] >> 16));
#pragma unroll
                for (int e = 0; e < 2; ++e) {
                    const int i = 8 * i8 + 2 * jj + e;
                    const float inv = exp2f(-(float)i * (LOG2_1E4 / 32.0f));
                    float sn, cs; sincos_rr(p * inv, sn, cs);
                    nql[e] = ql[e] * cs - qh[e] * sn; nqh[e] = qh[e] * cs + ql[e] * sn;
                    nkl[e] = (kl[e] * cs - kh[e] * sn) * 0.125f; nkh[e] = (kh[e] * cs + kl[e] * sn) * 0.125f;
                    Ktf[i * RS + c] = (bf16_t)(pk2(nkl[e] * wf, 0.f) & 0xffffu); Ktf[(32 + i) * RS + c] = (bf16_t)(pk2(nkh[e] * wf, 0.f) & 0xffffu);
                    Ktb[i * RS + c] = (bf16_t)(pk2(nkl[e] * wb, 0.f) & 0xffffu); Ktb[(32 + i) * RS + c] = (bf16_t)(pk2(nkh[e] * wb, 0.f) & 0xffffu);
                }
                oql[jj] = pk2(nql[0], nql[1]); oqh[jj] = pk2(nqh[0], nqh[1]); okl[jj] = pk2(nkl[0], nkl[1]); okh[jj] = pk2(nkh[0], nkh[1]);
            }
            *(u32x4*)(row + 8 * i8) = oql; *(u32x4*)(row + 32 + 8 * i8) = oqh; *(u32x4*)(row + 256 + 8 * i8) = okl; *(u32x4*)(row + 256 + 32 + 8 * i8) = okh;
#pragma unroll
            for (int it = 0; it < 2; ++it) {
                const int idx = tid + 512 * it, key = idx & 127, e8 = (idx >> 7) * 8;
                const u32x4 v = *(const u32x4*)(ZR + (t0 + key) * 1024 + 512 + h * 64 + e8);
#pragma unroll
                for (int i = 0; i < 8; ++i) Vt[(e8 + i) * RS + key] = (bf16_t)((v[i >> 1] >> (16 * (i & 1))) & 0xffffu);
            }
        }
        __syncthreads();
        {
            const int dir = wid >> 2, eb = (wid >> 1) & 1, db = wid & 1;
            const bf16_t* Kw = dir ? Ktb : Ktf;
            f32x16 acc;
#pragma unroll
            for (int i = 0; i < 16; ++i) acc[i] = 0.f;
#pragma unroll
            for (int s = 0; s < 8; ++s) {
                const bf16x8 a = *(const bf16x8*)(Vt + (32 * eb + r32) * RS + 16 * s + 8 * hi);
                const bf16x8 bb = *(const bf16x8*)(Kw + (32 * db + r32) * RS + 16 * s + 8 * hi);
                acc = MFMA32(a, bb, acc);
            }
            float* o = KVT + ((size_t)u * 2 + dir) * 4096;
#pragma unroll
            for (int r = 0; r < 16; ++r) o[(32 * eb + crow(r, hi)) * 64 + 32 * db + r32] = acc[r];
        }
        __syncthreads();
    }
}
__device__ __forceinline__ void ret_scan(const Params& P, int l, int tid) {
    const float* KVT = (const float*)(kws() + WS_KVT); bf16_t* RT = (bf16_t*)(kws() + WS_RT);
    const float* lr = (const float*)kin(26) + l * 8;
    for (int g = blockIdx.x * 512 + tid; g < 16 * 2 * 4096; g += gridDim.x * 512) {
        const int idx = g & 4095, dir = (g >> 12) & 1, bh = g >> 13, h = bh & 3;
        const float dc = expf(-expf(lr[dir * 4 + h]) * 128.0f);
        float kv[32];
#pragma unroll
        for (int n = 0; n < 32; ++n) kv[n] = KVT[((size_t)(bh * 32 + n) * 2 + dir) * 4096 + idx];
        float R = 0.f;
        if (dir == 0) {
#pragma unroll
            for (int n = 0; n < 32; ++n) { const size_t o = ((size_t)(bh * 32 + n) * 2 + 0) * 4096 + idx; RT[o] = (bf16_t)(pk2(R, 0.f) & 0xffffu); R = R * dc + kv[n]; } }
        else {
#pragma unroll
            for (int n = 31; n >= 0; --n) { const size_t o = ((size_t)(bh * 32 + n) * 2 + 1) * 4096 + idx; RT[o] = (bf16_t)(pk2(R, 0.f) & 0xffffu); R = R * dc + kv[n]; } }
    }
}

template <int CTRL> __device__ __forceinline__ float dpp_add(float x) { const int y = __builtin_amdgcn_update_dpp(0, __float_as_int(x), CTRL, 0xf, 0xf, false); return x + __int_as_float(y); }
__device__ __forceinline__ float row16_sum(float x) { x = dpp_add<0x128>(x); x = dpp_add<0x124>(x); x = dpp_add<0x122>(x); x = dpp_add<0x121>(x); return x; }
constexpr int SC_CH = 16, SC_BUF = SC_CH * (5 * 64 + 16), SC_YP = SC_CH * 64, SC_NB = 5;
template <int DIR> __device__ __forceinline__ void rwkv_scan_dir(const Params& P, unsigned char* lds, int sb, int tid) {
    float* buf = (float*)lds;
    float* ypart = buf + SC_NB * SC_BUF + 1024;
    const float* DEC = (const float*)(kws() + WS_DEC) + (size_t)DIR * T * 256; const float* KKA = (const float*)(kws() + WS_KKA) + (size_t)DIR * T * 256;
    const float* KMOD = (const float*)(kws() + WS_KMOD) + (size_t)DIR * T * 256; const float* KK = (const float*)(kws() + WS_KK); const float* RKV = (const float*)(kws() + WS_RKV);
    float* Y = (float*)(kws() + WS_Y) + (size_t)DIR * T * 256;
    const int chain = sb >> 2, rq = sb & 3, b = (chain >> 2) & 3, h = chain & 3;
    const int cbase = h * 64;
    const size_t row0 = (size_t)b * S;
    const int wid = tid >> 6, lane = tid & 63;
    const bool loader = wid >= 4;
    const int grp = wid - 4;
    const int ltid = tid - 256;
    f32x4 lr_[20], lv;
#define SC_LOAD(ck) do { _Pragma("unroll") for (int i = 0; i < 20; ++i) { const int wi = lane + 64 * (i & 3), st = wi >> 4, q4 = wi & 15; const int s = (ck) * SC_CH + st; const size_t gr = row0 + (DIR ? (S - 1 - s) : s); \
        const float* src_ = (i >> 2) == 0 ? DEC + gr * 256 : (i >> 2) == 1 ? KK + gr * 256 : (i >> 2) == 2 ? KKA + gr * 256 : (i >> 2) == 3 ? KMOD + gr * 256 : RKV + gr * 768; \
        lr_[i] = *(const f32x4*)(src_ + cbase + 4 * q4); } \
        { const int st = lane >> 2, q4 = lane & 3; const int s = (ck) * SC_CH + st; const size_t gr = row0 + (DIR ? (S - 1 - s) : s); lv = *(const f32x4*)(RKV + gr * 768 + 512 + cbase + rq * 16 + 4 * q4); } } while (0)
#define SC_STORE(ck) do { float* B_ = buf + ((ck) % SC_NB) * SC_BUF; _Pragma("unroll") for (int i = 0; i < 20; ++i) { const int wi = lane + 64 * (i & 3), st = wi >> 4, q4 = wi & 15; \
        *(f32x4*)(B_ + st * 336 + (i >> 2) * 64 + 4 * q4) = lr_[i]; } \
        { const int st = lane >> 2, q4 = lane & 3; *(f32x4*)(B_ + st * 336 + 320 + 4 * q4) = lv; } } while (0)
#define SC_YOUT(ck) do { const float* yp_ = ypart + ((ck) & 1) * SC_YP; const int st = ltid >> 4, rw = ltid & 15; \
        const f32x4 q_ = *(const f32x4*)(yp_ + ltid * 4); const int s = (ck) * SC_CH + st; const size_t gr = row0 + (DIR ? (S - 1 - s) : s); \
        Y[gr * 256 + cbase + rq * 16 + rw] = (q_.x + q_.y) + (q_.z + q_.w); } while (0)
    constexpr int NCH = S / SC_CH;
    if (loader) { SC_LOAD(grp); if (grp == 0) { SC_STORE(0); SC_LOAD(4); } }
    __syncthreads();
    const int rowi = (wid & 3) * 4 + (lane >> 4), j = lane & 15;
    f32x2 sA = {0.f, 0.f}, sB = {0.f, 0.f};
    for (int ck = 0; ck < NCH; ++ck) {
        if (loader) {
            if (ck + 1 < NCH && ((ck + 1) & 3) == grp) { SC_STORE(ck + 1); if (ck + 5 < NCH) SC_LOAD(ck + 5); }
            if (ck > 0) SC_YOUT(ck - 1);
        } else {
            const float* rp = buf + (ck % SC_NB) * SC_BUF + 4 * j;
            const float* vp = buf + (ck % SC_NB) * SC_BUF + 320 + rowi;
            int yoff = (ck & 1) * SC_YP + rowi * 4 + (j & 3); LAUNDER_V(yoff);
            float* yp = ypart + yoff;
            f32x4 w = *(const f32x4*)(rp), kk = *(const f32x4*)(rp + 64), kka = *(const f32x4*)(rp + 128), km = *(const f32x4*)(rp + 192), r = *(const f32x4*)(rp + 256);
            float v = *vp;
            f32x4 w1 = *(const f32x4*)(rp + 336), kk1 = *(const f32x4*)(rp + 336 + 64), kka1 = *(const f32x4*)(rp + 336 + 128), km1 = *(const f32x4*)(rp + 336 + 192), r1 = *(const f32x4*)(rp + 336 + 256);
            float v1 = vp[336];
#define LO2(x) __builtin_shufflevector(x, x, 0, 1)
#define HI2(x) __builtin_shufflevector(x, x, 2, 3)
#pragma unroll 8
            for (int st = 0; st < SC_CH; ++st) {
                const float* rn = rp + (st + 2) * 336;
                const f32x4 nw = *(const f32x4*)(rn), nkk = *(const f32x4*)(rn + 64), nkka = *(const f32x4*)(rn + 128), nkm = *(const f32x4*)(rn + 192), nr = *(const f32x4*)(rn + 256);
                const float nv = vp[(st + 2) * 336];
                f32x2 q = sA * LO2(kk); q = sB * HI2(kk) + q;
                float sk = q.x + q.y;
                float yy = 0.f;
                if (DIR == 1) { f32x2 yq = sA * LO2(r); yq = sB * HI2(r) + yq; yy = yq.x + yq.y; }
                sk = row16_sum(sk);
                f32x2 tA = LO2(km) * v, tB = HI2(km) * v;
                tA = sA * LO2(w) + tA; tB = sB * HI2(w) + tB;
                sA = LO2(kka) * sk + tA; sB = HI2(kka) * sk + tB;
                if (DIR == 0) { f32x2 yq = sA * LO2(r); yq = sB * HI2(r) + yq; yy = yq.x + yq.y; }
                yy = dpp_add<0x128>(yy); yy = dpp_add<0x124>(yy);
                yp[st * 64] = yy;
                w = w1; kk = kk1; kka = kka1; km = km1; r = r1; v = v1;
                w1 = nw; kk1 = nkk; kka1 = nkka; km1 = nkm; r1 = nr; v1 = nv;
            }
#undef LO2
#undef HI2
        }
        asm volatile("s_waitcnt lgkmcnt(0)\n\ts_barrier" ::: "memory");
    }
    if (loader) SC_YOUT(NCH - 1);
    __syncthreads();
#undef SC_LOAD
#undef SC_STORE
#undef SC_YOUT
}

__device__ __forceinline__ void rwkv_post(const Params& P, int l, int gw, int NGW, int lane) {
    const float* Y = (const float*)(kws() + WS_Y); const float* RKV = (const float*)(kws() + WS_RKV); const float* G = (const float*)(kws() + WS_G);
    bf16_t* MIX = (bf16_t*)(kws() + WS_H);
    const float* r_k = (const float*)kin(19) + l * 256; const float* ln_g = (const float*)kin(20) + l * 256; const float* ln_b = (const float*)kin(21) + l * 256;
    for (int it0 = gw; it0 < T * 4; it0 += 4 * NGW) {
        float y[4], r[4], k[4], v[4], g[4], lg[4], lb[4], rk[4];
#pragma unroll
        for (int q = 0; q < 4; ++q) { const int it = it0 + q * NGW; const size_t t = (size_t)(it >> 2); const int c = (it & 3) * 64 + lane;
            y[q] = Y[t * 256 + c] + Y[((size_t)T + t) * 256 + c]; r[q] = RKV[t * 768 + c]; k[q] = RKV[t * 768 + 256 + c]; v[q] = RKV[t * 768 + 512 + c]; g[q] = G[t * 256 + c];
            lg[q] = ln_g[c]; lb[q] = ln_b[c]; rk[q] = r_k[c]; }
#pragma unroll
        for (int q = 0; q < 4; ++q) { const int it = it0 + q * NGW; const size_t t = (size_t)(it >> 2); const int c = (it & 3) * 64 + lane;
            const float mean = wave_sum(y[q]) * (1.0f / 64.0f);
            const float dd = y[q] - mean;
            const float var = wave_sum(dd * dd) * (1.0f / 64.0f);
            const float yn = dd * (1.0f / sqrtf(var + 64e-5f)) * lg[q] + lb[q];
            const float bonus = wave_sum(r[q] * k[q] * rk[q]) * v[q];
            MIX[t * 1024 + c] = (bf16_t)(pk2((yn + bonus) * g[q], 0.f) & 0xffffu); }
    }
}

constexpr int AK = 104, AV = 72;
constexpr int AT_KB = 64 * AK * 2, AT_VB = 64 * AV * 2;
__device__ __forceinline__ float max3_asm(float a, float b, float c) { float r; asm("v_max3_f32 %0, %1, %2, %3" : "=v"(r) : "v"(a), "v"(b), "v"(c)); return r; }
__device__ __forceinline__ float max2_asm(float a, float b) { float r; asm("v_max_f32_e32 %0, %1, %2" : "=v"(r) : "v"(a), "v"(b)); return r; }
__device__ __forceinline__ float halves_max(float m) { auto rr = __builtin_amdgcn_permlane32_swap(__float_as_uint(m), __float_as_uint(m), false, false); return max2_asm(__uint_as_float(rr[0]), __uint_as_float(rr[1])); }
constexpr float ATT_THR = 12.0f;
__device__ __forceinline__ void attn_unit(const Params& P, unsigned char* lds, int b, int h, int qb, int tid) {
    const int lane = tid & 63, r32 = lane & 31, hi = lane >> 5, wid = tid >> 6;
    float* wsf = (float*)(lds + 2 * AT_KB + 2 * AT_VB) + wid * 64;
    const bf16_t* QB = (const bf16_t*)(kws() + WS_QB); const bf16_t* KVB = (const bf16_t*)(kws() + WS_KVB); const bf16_t* KPE = (const bf16_t*)(kws() + WS_KPE);
    const bf16_t* VTg = (const bf16_t*)(kws() + WS_VT) + (size_t)((b * 8 + h) * 64) * 4096;
    bf16_t* MIX = (bf16_t*)(kws() + WS_H); const int* pos = (const int*)kin(2);
    const size_t row0 = (size_t)b * S;
    const int q0 = qb * 256 + wid * 32;
    bf16x8 qr[6];
    {
        const size_t qrow = row0 + q0 + r32;
        float qf[6][8];
#pragma unroll
        for (int s = 0; s < 6; ++s) { const bf16x8 raw = *(const bf16x8*)(QB + qrow * 768 + h * 96 + 16 * s + 8 * hi);
#pragma unroll
            for (int j = 0; j < 8; ++j) qf[s][j] = bf2f((unsigned short)raw[j]); }
        const float p = (float)pos[qrow];
#pragma unroll
        for (int j = 0; j < 8; ++j) { const float inv = exp2f(-(float)(8 * hi + j) * (LOG2_1E4 / 16.0f)); float sn, cs; sincos_rr(p * inv, sn, cs);
            const float t1 = qf[4][j], t2 = qf[5][j]; qf[4][j] = t1 * cs - t2 * sn; qf[5][j] = t2 * cs + t1 * sn; }
        const float C2 = 0.10206207261596577f * LOG2E;
#pragma unroll
        for (int s = 0; s < 6; ++s) { u32x4 w; w.x = pk2(qf[s][0] * C2, qf[s][1] * C2); w.y = pk2(qf[s][2] * C2, qf[s][3] * C2); w.z = pk2(qf[s][4] * C2, qf[s][5] * C2); w.w = pk2(qf[s][6] * C2, qf[s][7] * C2);
            qr[s] = __builtin_bit_cast(bf16x8, w); }
    }
    const int key0 = tid / 12, part0 = tid % 12, key1 = (512 + (tid >> 1)) / 12, part1 = (512 + (tid >> 1)) % 12, half1 = tid & 1;
    const int ve = tid >> 3, vpart = tid & 7;
    u32x4 kA, vR; u32x2 kB;
    const bf16_t* kp0 = part0 < 8 ? KVB + (row0 + key0) * 1024 + h * 128 + part0 * 8 : KPE + (row0 + key0) * 32 + (part0 - 8) * 8;
    const bf16_t* kp1 = (part1 < 8 ? KVB + (row0 + key1) * 1024 + h * 128 + part1 * 8 : KPE + (row0 + key1) * 32 + (part1 - 8) * 8) + half1 * 4;
    const int ks0 = part0 < 8 ? 64 * 1024 : 64 * 32, ks1 = part1 < 8 ? 64 * 1024 : 64 * 32;
    const bf16_t* vp0 = VTg + (size_t)ve * 4096 + vpart * 8;
#define AT_LOADK(kt) do { kA = *(const u32x4*)(kp0 + (size_t)(kt) * ks0); kB = *(const u32x2*)(kp1 + (size_t)(kt) * ks1); } while (0)
#define AT_LOADV(kt) do { vR = *(const u32x4*)(vp0 + (kt) * 64); } while (0)
#define AT_STOREK(bi) do { bf16_t* Kw_ = (bf16_t*)(lds + (bi) * AT_KB); *(u32x4*)(Kw_ + key0 * AK + part0 * 8) = kA; *(u32x2*)(Kw_ + key1 * AK + part1 * 8 + half1 * 4) = kB; } while (0)
#define AT_STOREV(bi) do { bf16_t* Vw_ = (bf16_t*)(lds + 2 * AT_KB + (bi) * AT_VB); *(u32x4*)(Vw_ + ve * AV + vpart * 8) = vR; } while (0)
#define AT_QK(P0, P1, bi, CI) do { const bf16_t* Kt_ = (const bf16_t*)(lds + (bi) * AT_KB); P0 = CI; P1 = CI; \
        _Pragma("unroll") for (int s = 0; s < 6; ++s) { const bf16x8 a0_ = *(const bf16x8*)(Kt_ + r32 * AK + 16 * s + 8 * hi), a1_ = *(const bf16x8*)(Kt_ + (32 + r32) * AK + 16 * s + 8 * hi); \
            __builtin_amdgcn_s_setprio(1); P0 = MFMA32(a0_, qr[s], P0); P1 = MFMA32(a1_, qr[s], P1); __builtin_amdgcn_s_setprio(0); } } while (0)
    float mref, l_part = 0.f;
    f32x16 o0, o1, negm, sa0, sa1, sb0, sb1;
#pragma unroll
    for (int i = 0; i < 16; ++i) { o0[i] = 0.f; o1[i] = 0.f; negm[i] = 0.f; }
    AT_LOADK(0); AT_LOADV(0); AT_STOREK(0); AT_STOREV(0); AT_LOADK(1);
    __syncthreads();
    AT_QK(sa0, sa1, 0, negm);
    { float mx = fmaxf(sa0[0], sa1[0]);
#pragma unroll
      for (int i = 1; i < 16; ++i) mx = fmaxf(mx, fmaxf(sa0[i], sa1[i]));
      mx = fmaxf(mx, __shfl_xor(mx, 32));
      mref = mx;
#pragma unroll
      for (int i = 0; i < 16; ++i) { sa0[i] -= mx; sa1[i] -= mx; negm[i] = -mx; } }
    AT_STOREK(1); AT_LOADK(2); AT_LOADV(1);
    __syncthreads();
#define AT_STEP(C0, C1, N0, N1, kt) do { \
        if ((kt) + 2 < S / 64) AT_STOREK((kt) & 1); \
        if ((kt) + 1 < S / 64) AT_STOREV(((kt) + 1) & 1); \
        if ((kt) + 3 < S / 64) AT_LOADK((kt) + 3); \
        if ((kt) + 2 < S / 64) AT_LOADV((kt) + 2); \
        if ((kt) + 1 < S / 64) AT_QK(N0, N1, ((kt) + 1) & 1, negm); \
        float mx_ = max3_asm(C0[0], C0[1], C1[0]); float my_ = max3_asm(C0[2], C0[3], C1[1]); mx_ = max3_asm(mx_, C1[2], C1[3]); \
        _Pragma("unroll") for (int i = 4; i < 16; i += 4) { mx_ = max3_asm(mx_, C0[i], C0[i + 1]); my_ = max3_asm(my_, C0[i + 2], C0[i + 3]); mx_ = max3_asm(mx_, C1[i], C1[i + 1]); my_ = max3_asm(my_, C1[i + 2], C1[i + 3]); } \
        mx_ = halves_max(max2_asm(mx_, my_)); \
        if (__builtin_expect(__any(mx_ > ATT_THR), 0)) { \
            const float dl_ = fmaxf(mx_, 0.f); mref += dl_; const float f_ = __builtin_amdgcn_exp2f(-dl_); l_part *= f_; \
            _Pragma("unroll") for (int i = 0; i < 16; ++i) { C0[i] -= dl_; C1[i] -= dl_; N0[i] -= dl_; N1[i] -= dl_; negm[i] = -mref; } \
            if (hi == 0) wsf[r32] = f_; \
            LDSWAIT(); \
            _Pragma("unroll") for (int r = 0; r < 16; ++r) { const float fr_ = wsf[crow(r, hi)]; o0[r] *= fr_; o1[r] *= fr_; } \
        } \
        float rs0_ = 0.f, rs1_ = 0.f, rs2_ = 0.f, rs3_ = 0.f; \
        _Pragma("unroll") for (int i = 0; i < 16; i += 4) { \
            C0[i] = __builtin_amdgcn_exp2f(C0[i]); C1[i] = __builtin_amdgcn_exp2f(C1[i]); rs0_ += C0[i] + C1[i]; \
            C0[i + 1] = __builtin_amdgcn_exp2f(C0[i + 1]); C1[i + 1] = __builtin_amdgcn_exp2f(C1[i + 1]); rs1_ += C0[i + 1] + C1[i + 1]; \
            C0[i + 2] = __builtin_amdgcn_exp2f(C0[i + 2]); C1[i + 2] = __builtin_amdgcn_exp2f(C1[i + 2]); rs2_ += C0[i + 2] + C1[i + 2]; \
            C0[i + 3] = __builtin_amdgcn_exp2f(C0[i + 3]); C1[i + 3] = __builtin_amdgcn_exp2f(C1[i + 3]); rs3_ += C0[i + 3] + C1[i + 3]; } \
        l_part += (rs0_ + rs1_) + (rs2_ + rs3_); \
        { const bf16_t* Vt_ = (const bf16_t*)(lds + 2 * AT_KB + ((kt) & 1) * AT_VB); \
          _Pragma("unroll") for (int kb = 0; kb < 2; ++kb) _Pragma("unroll") for (int hf = 0; hf < 2; ++hf) { \
            u32x4 w_; \
            if (kb == 0) { w_.x = pk2(C0[8 * hf + 0], C0[8 * hf + 1]); w_.y = pk2(C0[8 * hf + 2], C0[8 * hf + 3]); w_.z = pk2(C0[8 * hf + 4], C0[8 * hf + 5]); w_.w = pk2(C0[8 * hf + 6], C0[8 * hf + 7]); } \
            else { w_.x = pk2(C1[8 * hf + 0], C1[8 * hf + 1]); w_.y = pk2(C1[8 * hf + 2], C1[8 * hf + 3]); w_.z = pk2(C1[8 * hf + 4], C1[8 * hf + 5]); w_.w = pk2(C1[8 * hf + 6], C1[8 * hf + 7]); } \
            const bf16x8 A_ = __builtin_bit_cast(bf16x8, w_); \
            const int kofs_ = 32 * kb + 16 * hf + 8 * hi; \
            const bf16x8 B0_ = *(const bf16x8*)(Vt_ + r32 * AV + kofs_), B1_ = *(const bf16x8*)(Vt_ + (32 + r32) * AV + kofs_); \
            __builtin_amdgcn_s_setprio(1); o0 = MFMA32(A_, B0_, o0); o1 = MFMA32(A_, B1_, o1); __builtin_amdgcn_s_setprio(0); } } \
        __syncthreads(); \
    } while (0)
    for (int kt = 0; kt < S / 64; kt += 2) {
        AT_STEP(sa0, sa1, sb0, sb1, kt);
        AT_STEP(sb0, sb1, sa0, sa1, kt + 1);
    }
    float l_run = l_part + __shfl_xor(l_part, 32);
    if (hi == 0) wsf[32 + r32] = l_run;
    LDSWAIT();
    int q0l = q0; LAUNDER_V(q0l);
#pragma unroll
    for (int r = 0; r < 16; ++r) {
        const float rl = 1.0f / wsf[32 + crow(r, hi)];
        bf16_t* orow = MIX + (row0 + q0l + crow(r, hi)) * 1024 + 256 + h * 64;
        orow[r32] = (bf16_t)(pk2(o0[r] * rl, 0.f) & 0xffffu); orow[32 + r32] = (bf16_t)(pk2(o1[r] * rl, 0.f) & 0xffffu);
    }
    LDSWAIT();
    __syncthreads();
#undef AT_LOADK
#undef AT_LOADV
#undef AT_STOREK
#undef AT_STOREV
#undef AT_QK
#undef AT_STEP
}

constexpr int RK = 72;
__device__ __forceinline__ void ret_out(const Params& P, int l, unsigned char* lds, int u, int tid) {
    const int lane = tid & 63, r32 = lane & 31, hi = lane >> 5, wid = tid >> 6;
    bf16_t* Kl = (bf16_t*)lds;
    bf16_t* Vt = Kl + 2 * 128 * RK;
    const bf16_t* ZR = (const bf16_t*)(kws() + WS_ZR); const bf16_t* RT = (const bf16_t*)(kws() + WS_RT); bf16_t* MIX = (bf16_t*)(kws() + WS_H);
    const float* lr = (const float*)kin(26) + l * 8; const float* gn = (const float*)kin(27) + l * 256;
    const int b = u >> 6, h = (u >> 4) & 3, np = u & 15;
    const float lgf2 = -expf(lr[h]) * LOG2E, lgb2 = -expf(lr[4 + h]) * LOG2E;
    const size_t t0 = (size_t)b * S + np * 256;
#pragma unroll
    for (int it = 0; it < 4; ++it) {
        const int idx = tid + 512 * it;
        { const int part = idx & 7, key = (idx >> 3) & 127, ck = idx >> 10;
          const u32x4 kv = *(const u32x4*)(ZR + (t0 + ck * 128 + key) * 1024 + 256 + h * 64 + part * 8);
          *(u32x4*)(Kl + (ck * 128 + key) * RK + part * 8) = kv; }
        { const int key = idx & 127, e8 = ((idx >> 7) & 7) * 8, ck = idx >> 10;
          const u32x4 v = *(const u32x4*)(ZR + (t0 + ck * 128 + key) * 1024 + 512 + h * 64 + e8);
#pragma unroll
          for (int i = 0; i < 8; ++i) Vt[(ck * 64 + e8 + i) * RS + key] = (bf16_t)((v[i >> 1] >> (16 * (i & 1))) & 0xffffu); }
    }
    __syncthreads();
    const int ck = wid >> 2, c0 = 32 * (wid & 3);
    const size_t tc = t0 + ck * 128;
    const int n = np * 2 + ck;
    bf16x8 qr[4];
#pragma unroll
    for (int s = 0; s < 4; ++s) qr[s] = *(const bf16x8*)(ZR + (tc + c0 + r32) * 1024 + h * 64 + 16 * s + 8 * hi);
    const bf16_t* Kc = Kl + ck * 128 * RK; const bf16_t* Vc = Vt + ck * 64 * RS;
    f32x16 o0, o1;
#pragma unroll
    for (int i = 0; i < 16; ++i) { o0[i] = 0.f; o1[i] = 0.f; }
    const int cq = c0 + r32;
#pragma unroll 1
    for (int kb = 0; kb < 4; ++kb) {
        f32x16 p;
#pragma unroll
        for (int i = 0; i < 16; ++i) p[i] = 0.f;
#pragma unroll
        for (int s = 0; s < 4; ++s) { const bf16x8 a = *(const bf16x8*)(Kc + (32 * kb + r32) * RK + 16 * s + 8 * hi); p = MFMA32(a, qr[s], p); }
#pragma unroll
        for (int r = 0; r < 16; ++r) { const int mkey = 32 * kb + crow(r, hi); const int df = cq - mkey;
            const float wgt = df >= 0 ? __builtin_amdgcn_exp2f(lgf2 * (float)df) : __builtin_amdgcn_exp2f(lgb2 * (float)(-df)); p[r] *= wgt; }
#pragma unroll
        for (int hf = 0; hf < 2; ++hf) {
            u32x4 w; w.x = pk2(p[8 * hf + 0], p[8 * hf + 1]); w.y = pk2(p[8 * hf + 2], p[8 * hf + 3]); w.z = pk2(p[8 * hf + 4], p[8 * hf + 5]); w.w = pk2(p[8 * hf + 6], p[8 * hf + 7]);
            const bf16x8 A = __builtin_bit_cast(bf16x8, w);
            const int kofs = 32 * kb + 16 * hf + 4 * hi;
            const s16x4 l0 = *(const s16x4*)(Vc + r32 * RS + kofs), h0 = *(const s16x4*)(Vc + r32 * RS + kofs + 8);
            const s16x4 l1 = *(const s16x4*)(Vc + (32 + r32) * RS + kofs), h1 = *(const s16x4*)(Vc + (32 + r32) * RS + kofs + 8);
            const bf16x8 B0 = __builtin_shufflevector(l0, h0, 0, 1, 2, 3, 4, 5, 6, 7), B1 = __builtin_shufflevector(l1, h1, 0, 1, 2, 3, 4, 5, 6, 7);
            o0 = MFMA32(A, B0, o0); o1 = MFMA32(A, B1, o1);
        }
    }
    const int unit = (b * 4 + h) * 32 + n;
#pragma unroll 1
    for (int dir = 0; dir < 2; ++dir) {
        const bf16_t* Rt = RT + ((size_t)unit * 2 + dir) * 4096;
        const float wq = dir == 0 ? __builtin_amdgcn_exp2f(lgf2 * (float)(cq + 1)) : __builtin_amdgcn_exp2f(lgb2 * (float)(128 - cq));
#pragma unroll
        for (int s = 0; s < 4; ++s) {
            u32x4 w;
#pragma unroll
            for (int j = 0; j < 4; ++j) w[j] = pk2(bf2f((unsigned short)qr[s][2 * j]) * wq, bf2f((unsigned short)qr[s][2 * j + 1]) * wq);
            const bf16x8 A = __builtin_bit_cast(bf16x8, w);
            const bf16x8 b0 = *(const bf16x8*)(Rt + r32 * 64 + 16 * s + 8 * hi), b1 = *(const bf16x8*)(Rt + (32 + r32) * 64 + 16 * s + 8 * hi);
            o0 = MFMA32(A, b0, o0); o1 = MFMA32(A, b1, o1);
        }
    }
    const float g0 = gn[h * 64 + r32], g1 = gn[h * 64 + 32 + r32];
    int c0f = c0; LAUNDER_V(c0f);
#pragma unroll
    for (int r = 0; r < 16; ++r) {
        const float mean = half_sum(o0[r] + o1[r]) * (1.0f / 64.0f);
        const float d0 = o0[r] - mean, d1 = o1[r] - mean;
        const float var = half_sum(d0 * d0 + d1 * d1) * (1.0f / 64.0f);
        const float rstd = 1.0f / sqrtf(var + 1e-5f);
        const size_t t = tc + c0f + crow(r, hi);
        const float ga = bf2f(ZR[t * 1024 + 768 + h * 64 + r32]), gb = bf2f(ZR[t * 1024 + 768 + h * 64 + 32 + r32]);
        const float sa = ga / (1.0f + __expf(-ga)), sb = gb / (1.0f + __expf(-gb));
        MIX[t * 1024 + 768 + h * 64 + r32] = (bf16_t)(pk2(sa * d0 * rstd * g0, 0.f) & 0xffffu);
        MIX[t * 1024 + 768 + h * 64 + 32 + r32] = (bf16_t)(pk2(sb * d1 * rstd * g1, 0.f) & 0xffffu);
    }
    __syncthreads();
}

#define LAS __attribute__((address_space(3)))
#define XB_TMO      128
#define XB_XCNT(j)  (256  + 64 * (j))
#define XB_XSUB(j)  (1280 + 64 * (j))
#define XB_XGEN(j)  (2304 + 64 * (j))
#define XB_TOP      3328
#define XB_TOPGEN   3392
#define XCD_BAR_WORDS 3456
#define XB_SPIN_CAP (1u << 18)

__device__ __forceinline__ unsigned xb_ld(unsigned* p)              { return __hip_atomic_load(p, __ATOMIC_RELAXED, __HIP_MEMORY_SCOPE_AGENT); }
__device__ __forceinline__ unsigned xb_add(unsigned* p, unsigned v) { return __hip_atomic_fetch_add(p, v, __ATOMIC_RELAXED, __HIP_MEMORY_SCOPE_AGENT); }
__device__ __forceinline__ unsigned xb_xcc_id() { return (unsigned)__builtin_amdgcn_s_getreg((3 << 11) | 20) & 0xFu; }
#define XB_SPIN(cond, bar) do { unsigned _sp = 0; while (cond) { __builtin_amdgcn_s_sleep(1); \
    if ((++_sp & 255u) == 0u) { if (xb_ld(&(bar)[XB_TMO])) break; if (_sp > XB_SPIN_CAP) { atomicAdd(&(bar)[XB_TMO], 1u); break; } } } } while (0)

struct XcdBarrier {
    unsigned* bar; unsigned x; int tid;
    volatile LAS unsigned* st;
};

__device__ __forceinline__ XcdBarrier xcd_barrier_post(unsigned* bar, volatile LAS unsigned* st) {
    XcdBarrier b; b.bar = bar; b.x = xb_xcc_id(); b.st = st;
    if (threadIdx.x == 0) (void)xb_add(&bar[XB_XCNT(b.x)], 1u);
    return b;
}
__device__ __forceinline__ void xcd_barrier_complete(unsigned* bar, unsigned x, unsigned& nloc, unsigned& nx) {
    const unsigned G = gridDim.x * gridDim.y * gridDim.z;
    unsigned sum, cnt, mine, sp = 0u;
    for (;;) {
        sum = 0u; cnt = 0u; mine = 0u;
#pragma unroll
        for (unsigned j = 0; j < 16; ++j) { const unsigned c = xb_ld(&bar[XB_XCNT(j)]); sum += c; cnt += (c > 0u) ? 1u : 0u; mine = (j == x) ? c : mine; }
        if (sum == G) break;
        __builtin_amdgcn_s_sleep(1);
        if ((++sp & 255u) == 0u) { if (xb_ld(&bar[XB_TMO])) break; if (sp > XB_SPIN_CAP) { atomicAdd(&bar[XB_TMO], 1u); break; } }
    }
    nloc = mine > 0u ? mine : 1u; nx = cnt > 0u ? cnt : 1u;
}

__device__ __forceinline__ void xcd_barrier(const XcdBarrier& b) {
    asm volatile("s_waitcnt vmcnt(0)" ::: "memory");
    __syncthreads();
    if (b.tid == 0) {
        unsigned* bar = b.bar;
        __builtin_amdgcn_s_waitcnt(0);
        unsigned nloc = b.st[0], nx = b.st[1];
        if (nloc == 0u) { xcd_barrier_complete(bar, b.x, nloc, nx); b.st[0] = nloc; b.st[1] = nx; }
        const unsigned old = xb_add(&bar[XB_XSUB(b.x)], 1u);
        const unsigned gen = old / nloc;
        if (old + 1u == (gen + 1u) * nloc) {
            __builtin_amdgcn_fence(__ATOMIC_RELEASE, "agent");
            asm volatile("s_waitcnt vmcnt(0)" ::: "memory");
            const unsigned og = xb_add(&bar[XB_TOP], 1u);
            const unsigned tg = og / nx;
            if (og + 1u == (tg + 1u) * nx) xb_add(&bar[XB_TOPGEN], 1u);
            else XB_SPIN(xb_ld(&bar[XB_TOPGEN]) == tg, bar);
            __builtin_amdgcn_fence(__ATOMIC_ACQUIRE, "agent");
            xb_add(&bar[XB_XGEN(b.x)], 1u);
            asm volatile("s_waitcnt vmcnt(0)" ::: "memory");
        } else {
            XB_SPIN(xb_ld(&bar[XB_XGEN(b.x)]) == gen, bar);
            __builtin_amdgcn_fence(__ATOMIC_ACQUIRE, "agent");
            asm volatile("s_waitcnt vmcnt(0)" ::: "memory");
        }
    }
    __syncthreads();
}

constexpr size_t WS_BAR = 819200;
__global__ void __launch_bounds__(512, 2) fwd_megakernel(Params Pdummy) {
    extern __shared__ __attribute__((aligned(16))) unsigned char lds[];
    cg::grid_group grid = cg::this_grid();
    const int G = gridDim.x, bid = blockIdx.x;
    const int wave_s = __builtin_amdgcn_readfirstlane((int)threadIdx.x >> 6);
#define HWTID() (wave_s * 64 + (int)__builtin_amdgcn_mbcnt_hi(~0u, __builtin_amdgcn_mbcnt_lo(~0u, 0u)))
    const Params& P = Pdummy;
    PG8_LAS unsigned char* ldsl = (PG8_LAS unsigned char*)lds;
    unsigned* barw = (unsigned*)(kws() + WS_BAR);
    volatile LAS unsigned* MISCp = (volatile LAS unsigned*)(ldsl + 131072 + 512);
    { int tid = threadIdx.x; LAUNDER_V(tid);
      if (bid == 0) for (int i = tid; i < XCD_BAR_WORDS; i += 512) __hip_atomic_store(barw + i, 0u, __ATOMIC_RELAXED, __HIP_MEMORY_SCOPE_AGENT);
      if (bid == 0 && tid < 64) __hip_atomic_store((unsigned*)(kws() + WS_CTR) + tid * 64, 0u, __ATOMIC_RELAXED, __HIP_MEMORY_SCOPE_AGENT);
      if (tid < 2) MISCp[tid] = 0u;
      __threadfence();
      __syncthreads();
#ifndef SKIP_MOD
      phase_mod(P, lds, tid);
#endif
    }
    grid.sync();
    (void)xcd_barrier_post(barw, MISCp);
    for (int step = 0; step < L * 14; ++step) {
        const int l = step / 14, k = step % 14;
        if (k == 7) continue;
#ifndef REPMASK
#define REPMASK 0
#endif
#ifndef SUBMASK
#define SUBMASK 0
#endif
        const int nrep = ((REPMASK >> k) & 1) ? 2 : 1;
        for (int rep = 0; rep < nrep; ++rep) {
        int tid = HWTID(); LAUNDER_V(tid);
        const int lane = tid & 63, wave = tid >> 6;
        const int vcu = (G % 8 == 0) ? (bid % 8) * (G / 8) + bid / 8 : bid;
        const int gw = vcu * 8 + wave, NGW = G * 8;
        unsigned char* ws = kws();
        const float* modl = (const float*)(ws + WS_MOD) + (size_t)l * 4 * 9216;
        pg8::Gemm g{nullptr, nullptr, 0, 0, 0}; pg8::EpiX E{0, nullptr, nullptr, nullptr, 0.f, 0}; bool do_gemm = false;
        switch (k) {
        case 0:
#ifndef SKIP_CONV
            convert_weights(P, l, lds, gw, NGW, wave, lane);
#endif
            norm_rows(P, l == 0 ? (const float*)kin(0) : kout(), l == 0 ? kout() : nullptr, l, 0, gw, NGW, lane);
            break;
        case 1:
            g = pg8::Gemm{(const bf16_t*)(ws + WS_H), (const bf16_t*)(ws + WS_WBF + WB_W1A), T, 5632, 1024}; E = pg8::EpiX{0, nullptr, (bf16_t*)(ws + WS_A), nullptr, 0.f, FF}; do_gemm = true; break;
        case 2:
            g = pg8::Gemm{(const bf16_t*)(ws + WS_A), (const bf16_t*)(ws + WS_WBF + WB_W2A), T, 1024, FF}; E = pg8::EpiX{1, kout(), nullptr, modl + 2 * 1024, 0.5f, 0}; do_gemm = true; break;
        case 3:
            norm_rows(P, kout(), nullptr, l, 3, gw, NGW, lane); break;
        case 4:
            g = pg8::Gemm{(const bf16_t*)(ws + WS_H), (const bf16_t*)(ws + WS_WBF + WB_WIN), T, 3072, 1024}; E = pg8::EpiX{2, (float*)(ws + WS_ZF), (bf16_t*)(ws + WS_ZR), nullptr, 0.f, 0}; do_gemm = true; break;
        case 5:
#ifndef SKIP_RPREP
            rwkv_prep(P, l, lds, tid);
#endif
#ifndef SKIP_MPREP
            mla_prep(P, l, gw, NGW, lane);
#endif
            __syncthreads();
#ifndef SKIP_RSTATE
            if (rep == 0) ret_state(P, l, lds, tid);
#endif
            break;
        case 6:
#ifndef SKIP_RSCAN
            ret_scan(P, l, tid);
#endif
            g = pg8::Gemm{(const bf16_t*)(ws + WS_CQN), (const bf16_t*)(ws + WS_WBF + WB_WUQ), T, 768, 384}; E = pg8::EpiX{3, nullptr, (bf16_t*)(ws + WS_QB), nullptr, 0.f, 768}; do_gemm = true; break;
        case 7:
            break;
        case 8:
#ifndef SKIP_SCAN
            for (int sr = 0; sr < ((SUBMASK & 1) ? 2 : 1); ++sr) {
            const int sbx = (((bid & 7) + 8 * ((bid >> 3) >> 2)) << 2) | ((bid >> 3) & 3);
            if (bid < 128) { if (bid >= 64) rwkv_scan_dir<1>(P, lds, sbx, tid); else rwkv_scan_dir<0>(P, lds, sbx, tid); }
            __syncthreads();
            }
#endif
            {
                unsigned* ctrl = (unsigned*)(kws() + WS_CTR) + l * 16 * 64;
                volatile unsigned* slot = (volatile unsigned*)(lds + 131072 + 1024);
                const int x0 = (int)(xb_xcc_id() & 7u);
                volatile unsigned* avail = slot + 4;
                for (;;) {
                    __syncthreads();
                    if (tid < 9) avail[tid] = __hip_atomic_load(ctrl + tid * 64, __ATOMIC_RELAXED, __HIP_MEMORY_SCOPE_AGENT);
                    __syncthreads();
                    int xs = 0;
                    for (; xs < 9; ++xs) { const int q_ = xs < 8 ? ((x0 + xs) & 7) : 8; if (avail[q_] < (xs < 8 ? 64u : 256u)) break; }
                    if (xs == 9) break;
                    const int qx = xs < 8 ? ((x0 + xs) & 7) : 8;
                    const unsigned qn = xs < 8 ? 64u : 256u;
                    for (;;) {
                        __syncthreads();
                        if (tid == 0) *slot = atomicAdd(ctrl + qx * 64, 1u);
                        __syncthreads();
                        const unsigned u = *slot;
                        if (u >= qn) break;
                        int tq = tid; LAUNDER_V(tq);
                        if (xs < 8) { const int bh = qx * 4 + (int)(u >> 4); attn_unit(P, lds, bh >> 3, bh & 7, (int)(u & 15), tq); }
                        else ret_out(P, l, lds, (int)u, tq);
                    }
                }
            }
            break;
        case 9:
#ifndef SKIP_RPOST
            rwkv_post(P, l, gw, NGW, lane);
#endif
            break;
        case 10:
            g = pg8::Gemm{(const bf16_t*)(ws + WS_H), (const bf16_t*)(ws + WS_WBF + WB_WOUT), T, 1024, 1024}; E = pg8::EpiX{1, kout(), nullptr, modl + 5 * 1024, 1.0f, 0}; do_gemm = true; break;
        case 11:
            norm_rows(P, kout(), nullptr, l, 6, gw, NGW, lane); break;
        case 12:
            g = pg8::Gemm{(const bf16_t*)(ws + WS_H), (const bf16_t*)(ws + WS_WBF + WB_W1B), T, 5632, 1024}; E = pg8::EpiX{0, nullptr, (bf16_t*)(ws + WS_A), nullptr, 0.f, FF}; do_gemm = true; break;
        default:
            g = pg8::Gemm{(const bf16_t*)(ws + WS_A), (const bf16_t*)(ws + WS_WBF + WB_W2B), T, 1024, FF}; E = pg8::EpiX{1, kout(), nullptr, modl + 8 * 1024, 0.5f, 0}; do_gemm = true; break;
        }
        if (rep > 0 && E.MODE == 1) E.coef = 0.f;
        if (do_gemm) {
            const int ngemm = (k == 6) ? 2 : 1;
            for (int gi = 0; gi < ngemm; ++gi) {
                int tg = tid; LAUNDER_V(tg);
                if (gi == 1) { g = pg8::Gemm{(const bf16_t*)(ws + WS_CKVN), (const bf16_t*)(ws + WS_WBF + WB_WUKV), T, 1024, 256}; E = pg8::EpiX{4, (float*)(ws + WS_VT), (bf16_t*)(ws + WS_KVB), nullptr, 0.f, 1024}; }
                pg8::StaticOrder So; So.init(g.M, g.N, G, bid); pg8::gemm_phase<pg8::EpiX, pg8::StaticOrder, true, true>(ldsl, g, So, E, tg);
            }
        }
        { XcdBarrier xb; xb.bar = (unsigned*)(kws() + WS_BAR); xb.x = xb_xcc_id(); xb.tid = tid; xb.st = (volatile LAS unsigned*)(ldsl + 131072 + 512); xcd_barrier(xb); }
        }
    }
    { int tid = HWTID(); LAUNDER_V(tid);
      const int lane = tid & 63, wave = tid >> 6;
      const int vcu = (G % 8 == 0) ? (bid % 8) * (G / 8) + bid / 8 : bid;
      final_norm(P, vcu * 8 + wave, G * 8, lane); }
}
}

extern "C" void kernel_launch(void* const* d_in, const int* in_sizes, int n_in, void* d_out, int out_size, void* d_ws, size_t ws_size, hipStream_t stream) {
    static int grid = 0;
    if (grid == 0) {
        if (n_in != 29 || out_size != mk::T * mk::D || ws_size < mk::WS_END) { fprintf(stderr, "kernel_launch: unexpected shapes (n_in %d, out %d, ws %zu)\n", n_in, out_size, ws_size); grid = -1; return; }
        int dev = 0, cus = 0, per_cu = 0;
        hipGetDevice(&dev);
        hipDeviceGetAttribute(&cus, hipDeviceAttributeMultiprocessorCount, dev);
        hipFuncSetAttribute((const void*)mk::fwd_megakernel, hipFuncAttributeMaxDynamicSharedMemorySize, mk::LDS_BYTES);
        hipOccupancyMaxActiveBlocksPerMultiprocessor(&per_cu, (const void*)mk::fwd_megakernel, 512, mk::LDS_BYTES);
        if (per_cu < 1) per_cu = 1;
        grid = cus * per_cu;
        (void)hipGetLastError();
    }
    if (grid < 0) return;
    mk::Params p{};
    for (int i = 0; i < 29; ++i) p.in[i] = d_in[i];
    p.out = (float*)d_out; p.ws = (unsigned char*)d_ws;
    void* args[] = {&p};
    hipError_t e = hipLaunchCooperativeKernel((const void*)mk::fwd_megakernel, dim3(grid), dim3(512), args, mk::LDS_BYTES, stream);
    if (e != hipSuccess) fprintf(stderr, "cooperative launch failed: %s (grid %d)\n", hipGetErrorString(e), grid);
}
```

```cpp
#include <hip/hip_runtime.h>
#include <hip/hip_cooperative_groups.h>
#include <cstdio>
#include <cstdint>
#include <cmath>
namespace cg = cooperative_groups;
namespace pg8 {
#define PG8_LAS __attribute__((address_space(3)))
typedef unsigned short bf16_t;
typedef short bf16x8 __attribute__((ext_vector_type(8)));
typedef float f32x4 __attribute__((ext_vector_type(4)));
typedef unsigned u32x4 __attribute__((ext_vector_type(4)));
constexpr int BM = 256, BK = 64, HALF = 128, HTB = HALF * BK * 2  , STAGE_BYTES = 8 * HTB, NXCD = 8, WGM = 8;

__host__ __device__ __forceinline__ int lds_byte(int r, int c) { const int st = (r >> 4) * 2 + (c >> 5), rr = r & 15, cc = c & 31, ob = rr * 64 + cc * 2; return st * 1024 + (ob ^ (((ob >> 9) & 1) << 5)); }
__host__ __device__ __forceinline__ void stage_rc(int b, int& R, int& C) { const int st = b / 1024, sb = b % 1024, swz = sb ^ (((sb >> 9) & 1) << 5); R = (st >> 1) * 16 + swz / 64; C = (st & 1) * 32 + (swz % 64) / 2; }
__host__ __device__ __forceinline__ int perm32(int rho) { const int n = rho >> 4, i = rho & 15; return 8 * (i >> 2) + 4 * n + (i & 3); }

struct Unit { int pm, pn; };
struct Gemm { const bf16_t* A; const bf16_t* Bt; int M, N, K; };

struct StaticOrder {
    int nM, nN, nwg, G, c;
    __host__ __device__ void init(int M, int N, int G_, int c_) { nM = M / BM; nN = N / BM; nwg = nM * nN; G = G_; c = c_; }
    __host__ __device__ bool next(int i, Unit& u) const {
        const long L = (long)i * G + c; if (L >= nwg) return false;
        int wgid = (int)L; { const int q = nwg / NXCD, r = nwg % NXCD, xcd = wgid % NXCD, off = wgid / NXCD; wgid = (xcd < r ? xcd * (q + 1) : r * (q + 1) + (xcd - r) * q) + off; }
        const int nig = WGM * nN, gid = wgid / nig, fm = gid * WGM, gsz = (nM - fm) < WGM ? (nM - fm) : WGM;
        u.pm = fm + ((wgid % nig) % gsz); u.pn = (wgid % nig) / gsz; return true;
    }
    __device__ __forceinline__ void a_ready(const Unit&) const {}
    __device__ __forceinline__ void done(const Unit&) const {}
};

__device__ __forceinline__ unsigned cvt_pk_bf16(float lo, float hi) { unsigned r; asm volatile("v_cvt_pk_bf16_f32 %0, %1, %2" : "=v"(r) : "v"(lo), "v"(hi)); return r; }
typedef float f32x2 __attribute__((ext_vector_type(2)));
typedef unsigned u32x2e __attribute__((ext_vector_type(2)));
typedef __bf16 bf16x2e __attribute__((ext_vector_type(2)));
__device__ __forceinline__ unsigned pk_bf16_rne(float lo, float hi) { f32x2 v = {lo, hi}; bf16x2e b = __builtin_convertvector(v, bf16x2e); return __builtin_bit_cast(unsigned, b); }
__device__ __forceinline__ float silu_f(float x) { return x * __builtin_amdgcn_rcpf(1.0f + __expf(-x)); }
struct EpiX {
    int MODE;
    static constexpr bool PERM = false, AFTER_DRAIN = false;
    float* F; bf16_t* Hh; const float* gv; float coef; int ldo;
    __device__ __forceinline__ void operator()(const f32x4 (&acc)[2][2][4][2], const Unit& u, int wr, int wc, int fr, int fq) const {
#pragma unroll
        for (int ai = 0; ai < 2; ++ai)
#pragma unroll
            for (int m = 0; m < 4; ++m) {
                const int r = u.pm * BM + ai * HALF + wr * 64 + m * 16 + fr;
#pragma unroll
                for (int bj = 0; bj < 2; ++bj) {
                    const int cb = u.pn * BM + bj * HALF + wc * 32;
                    const f32x4 v0 = acc[ai][bj][m][0], v1 = acc[ai][bj][m][1];
                    if (MODE == 0) {
                        u32x2e w; w.x = pk_bf16_rne(silu_f(v0[0]) * v1[0], silu_f(v0[1]) * v1[1]); w.y = pk_bf16_rne(silu_f(v0[2]) * v1[2], silu_f(v0[3]) * v1[3]);
                        *(u32x2e*)(Hh + (size_t)r * ldo + (cb >> 1) + 4 * fq) = w;
                    } else if (MODE == 1) {
                        const int b = r >> 12;
#pragma unroll
                        for (int n = 0; n < 2; ++n) { const int c = cb + 16 * n + 4 * fq; const f32x4 g = *(const f32x4*)(gv + b * 9216 + c); f32x4* xp = (f32x4*)(F + (size_t)r * 1024 + c);
                            f32x4 x = *xp; x += (n == 0 ? v0 : v1) * g * coef; *xp = x; }
                    } else if (MODE == 2) {
                        if (u.pn < 8) {
                            *(f32x4*)(F + (size_t)r * 2048 + cb + 4 * fq) = v0; *(f32x4*)(F + (size_t)r * 2048 + cb + 16 + 4 * fq) = v1;
                        } else {
                            u32x2e w0, w1; w0.x = pk_bf16_rne(v0[0], v0[1]); w0.y = pk_bf16_rne(v0[2], v0[3]); w1.x = pk_bf16_rne(v1[0], v1[1]); w1.y = pk_bf16_rne(v1[2], v1[3]);
                            *(u32x2e*)(Hh + (size_t)r * 1024 + (cb - 2048) + 4 * fq) = w0; *(u32x2e*)(Hh + (size_t)r * 1024 + (cb - 2048) + 16 + 4 * fq) = w1;
                        }
                    } else if (MODE == 4 && wc >= 2) {
                        const int hh = u.pn * 2 + bj, e0 = (wc - 2) * 32 + 4 * fq, bb = r >> 12, ss = r & 4095;
                        const int ssp = (ss & ~12) | ((ss & 4) << 1) | ((ss & 8) >> 1);
                        bf16_t* vt = (bf16_t*)F + ((size_t)((bb * 8 + hh) * 64 + e0)) * 4096 + ssp;
#pragma unroll
                        for (int j = 0; j < 4; ++j) { vt[(size_t)j * 4096] = (bf16_t)(pk_bf16_rne(v0[j], 0.f) & 0xffffu); vt[(size_t)(16 + j) * 4096] = (bf16_t)(pk_bf16_rne(v1[j], 0.f) & 0xffffu); }
                    } else {
                        u32x2e w0, w1; w0.x = pk_bf16_rne(v0[0], v0[1]); w0.y = pk_bf16_rne(v0[2], v0[3]); w1.x = pk_bf16_rne(v1[0], v1[1]); w1.y = pk_bf16_rne(v1[2], v1[3]);
                        *(u32x2e*)(Hh + (size_t)r * ldo + cb + 4 * fq) = w0; *(u32x2e*)(Hh + (size_t)r * ldo + cb + 16 + 4 * fq) = w1;
                    }
                }
            }
    }
};
template <class Epi, class Sched, bool ALIGN_EPI = false, bool SP2 = false>
__device__ __forceinline__ void gemm_phase(PG8_LAS unsigned char* lds, const Gemm g, const Sched& S, const Epi& E, int tid_in) {
    int tid_l = tid_in; asm volatile("" : "+v"(tid_l));
    const int tid = tid_l, wid = __builtin_amdgcn_readfirstlane(tid >> 6), lane = tid & 63, wr = wid >> 2, wc = wid & 3, fr = lane & 15, fq = lane >> 4;
    const int K = g.K, nt = K / BK;
    unsigned voffA[2], voffB[2];
#pragma unroll
    for (int i = 0; i < 2; ++i) { int R, C; stage_rc(tid * 16 + i * 8192, R, C); const int Rb = Epi::PERM ? ((R & ~31) + perm32(R & 31)) : R;
        voffA[i] = (unsigned)(R * K + C) * 2u; voffB[i] = (unsigned)(Rb * K + C) * 2u; }
    const size_t kstep = (size_t)(BK * 2);
    const size_t hstep = (size_t)HALF * K * 2;
    const size_t tstep = 2 * hstep;
    const unsigned ldsw = (unsigned)wid * 1024u;
    const int aoff = lds_byte(wr * 64 + fr, fq * 8), boff = lds_byte(wc * 32 + fr, fq * 8);
#define PG8_SA(b, h) (((b) * 2 + (h)) * HTB)
#define PG8_SB(b, h) ((4 + (b) * 2 + (h)) * HTB)
#define PG8_STAGE(bufoff, gbase, voff) do { _Pragma("unroll") for (int _i = 0; _i < 2; ++_i) \
        __builtin_amdgcn_global_load_lds((const unsigned*)((const char*)(gbase) + (voff)[_i]), (PG8_LAS unsigned*)(lds + (bufoff) + ldsw + _i * 8192), 16, 0, 0); } while (0)
#define PG8_LDA(dst, b, h) do { _Pragma("unroll") for (int m = 0; m < 4; ++m) _Pragma("unroll") for (int k = 0; k < 2; ++k) dst[m][k] = *(const PG8_LAS bf16x8*)(lds + PG8_SA(b, h) + aoff + m * 2048 + k * 1024); } while (0)
#define PG8_LDB(dst, b, h) do { _Pragma("unroll") for (int n = 0; n < 2; ++n) _Pragma("unroll") for (int k = 0; k < 2; ++k) dst[n][k] = *(const PG8_LAS bf16x8*)(lds + PG8_SB(b, h) + boff + n * 2048 + k * 1024); } while (0)
#define PG8_MMA(ai, bj, At, Bt) do { __builtin_amdgcn_s_setprio(1); _Pragma("unroll") for (int m = 0; m < 4; ++m) _Pragma("unroll") for (int n = 0; n < 2; ++n) _Pragma("unroll") for (int k = 0; k < 2; ++k) \
        acc[ai][bj][m][n] = __builtin_amdgcn_mfma_f32_16x16x32_bf16(Bt[n][k], At[m][k], acc[ai][bj][m][n], 0, 0, 0); __builtin_amdgcn_s_setprio(0); } while (0)
#define PG8_WAIT_V(n) asm volatile("s_waitcnt vmcnt(" #n ")" ::: "memory")
#define PG8_WAIT_L(n) asm volatile("s_waitcnt lgkmcnt(" #n ")" ::: "memory")
#define PG8_BAR __builtin_amdgcn_s_barrier()
#define PG8_SCHED __builtin_amdgcn_sched_barrier(0)
    Unit cur, nxt; int ui = 0;
    if (!S.next(0, cur)) return;
    f32x4 acc[2][2][4][2];
#pragma unroll
    for (int a = 0; a < 2; ++a)
#pragma unroll
        for (int b = 0; b < 2; ++b)
#pragma unroll
            for (int m = 0; m < 4; ++m)
#pragma unroll
                for (int n = 0; n < 2; ++n) acc[a][b][m][n] = (f32x4){0.f, 0.f, 0.f, 0.f};
    bf16x8 At[4][2], B0[2][2], B1[2][2];
    const char* cA = (const char*)g.A + (size_t)cur.pm * tstep; const char* cB = (const char*)g.Bt + (size_t)cur.pn * tstep;
    S.a_ready(cur);
    if constexpr (SP2) {
        PG8_STAGE(PG8_SB(0, 0), cB, voffB); PG8_STAGE(PG8_SB(0, 1), cB + hstep, voffB); PG8_STAGE(PG8_SA(0, 0), cA, voffA); PG8_STAGE(PG8_SA(0, 1), cA + hstep, voffA);
        if (wr == 1) PG8_BAR;
        PG8_WAIT_V(2); PG8_BAR;
        PG8_STAGE(PG8_SB(1, 0), cB + kstep, voffB); PG8_STAGE(PG8_SA(1, 0), cA + kstep, voffA); PG8_STAGE(PG8_SB(1, 1), cB + hstep + kstep, voffB);
        PG8_WAIT_V(6); PG8_BAR;
    } else {
        PG8_STAGE(PG8_SB(0, 0), cB, voffB); PG8_STAGE(PG8_SA(0, 0), cA, voffA); PG8_STAGE(PG8_SB(0, 1), cB + hstep, voffB); PG8_STAGE(PG8_SA(0, 1), cA + hstep, voffA);
        if (wr == 1) PG8_BAR;
        PG8_WAIT_V(4); PG8_BAR;
        PG8_STAGE(PG8_SB(1, 0), cB + kstep, voffB); PG8_STAGE(PG8_SA(1, 0), cA + kstep, voffA); PG8_STAGE(PG8_SB(1, 1), cB + hstep + kstep, voffB);
        PG8_WAIT_V(6); PG8_BAR;
    }
    for (;;) {
        const bool has_next = S.next(ui + 1, nxt);
        const char* nA = has_next ? (const char*)g.A + (size_t)nxt.pm * tstep : cA; const char* nB = has_next ? (const char*)g.Bt + (size_t)nxt.pn * tstep : cB;
        for (int t = 0; t < nt; t += 2) {
            const bool last = (t == nt - 2);
            const char* a1 = cA + (size_t)(t + 1) * kstep;
            const char* a2 = last ? nA : cA + (size_t)(t + 2) * kstep; const char* b2 = last ? nB : cB + (size_t)(t + 2) * kstep;
            const char* a3 = a2 + kstep; const char* b3 = b2 + kstep;
            if (last && has_next) S.a_ready(nxt);
            if constexpr (SP2) {
            PG8_LDB(B0, 0, 0); PG8_LDB(B1, 0, 1); PG8_SCHED; PG8_LDA(At, 0, 0); PG8_STAGE(PG8_SA(1, 1), a1 + hstep, voffA);
            PG8_WAIT_V(8); PG8_WAIT_L(0); PG8_BAR; PG8_MMA(0, 0, At, B0); PG8_MMA(0, 1, At, B1); PG8_BAR; PG8_SCHED;
            PG8_LDA(At, 0, 1); PG8_STAGE(PG8_SB(0, 0), b2, voffB); PG8_STAGE(PG8_SB(0, 1), b2 + hstep, voffB); PG8_STAGE(PG8_SA(0, 0), a2, voffA);
            PG8_WAIT_V(8); PG8_WAIT_L(0); PG8_BAR; PG8_MMA(1, 0, At, B0); PG8_MMA(1, 1, At, B1); PG8_BAR; PG8_SCHED;
            PG8_LDB(B0, 1, 0); PG8_LDB(B1, 1, 1); PG8_SCHED; PG8_LDA(At, 1, 0); PG8_STAGE(PG8_SA(0, 1), a2 + hstep, voffA);
            PG8_WAIT_V(8); PG8_WAIT_L(0); PG8_BAR; PG8_MMA(0, 0, At, B0); PG8_MMA(0, 1, At, B1); PG8_BAR; PG8_SCHED;
            PG8_LDA(At, 1, 1); PG8_STAGE(PG8_SB(1, 0), b3, voffB); PG8_STAGE(PG8_SB(1, 1), b3 + hstep, voffB); PG8_STAGE(PG8_SA(1, 0), a3, voffA);
            PG8_WAIT_V(8); PG8_WAIT_L(0); PG8_BAR; PG8_MMA(1, 0, At, B0); PG8_MMA(1, 1, At, B1); PG8_BAR; PG8_SCHED;
            } else {
            PG8_LDB(B0, 0, 0); PG8_SCHED; PG8_LDA(At, 0, 0); PG8_STAGE(PG8_SA(1, 1), a1 + hstep, voffA);
            PG8_WAIT_L(8); PG8_BAR; PG8_WAIT_L(0); PG8_MMA(0, 0, At, B0); PG8_BAR; PG8_SCHED;
            PG8_LDB(B1, 0, 1); PG8_STAGE(PG8_SB(0, 0), b2, voffB);
            PG8_BAR; PG8_WAIT_L(0); PG8_MMA(0, 1, At, B1); PG8_BAR;
            PG8_LDA(At, 0, 1); PG8_STAGE(PG8_SA(0, 0), a2, voffA);
            PG8_BAR; PG8_WAIT_L(0); PG8_MMA(1, 0, At, B0); PG8_BAR; PG8_SCHED;
            PG8_STAGE(PG8_SB(0, 1), b2 + hstep, voffB);
            PG8_WAIT_V(6); PG8_BAR; PG8_MMA(1, 1, At, B1); PG8_BAR;
            PG8_LDB(B0, 1, 0); PG8_SCHED; PG8_LDA(At, 1, 0); PG8_STAGE(PG8_SA(0, 1), a2 + hstep, voffA);
            PG8_WAIT_L(8); PG8_BAR; PG8_WAIT_L(0); PG8_MMA(0, 0, At, B0); PG8_BAR; PG8_SCHED;
            PG8_LDB(B1, 1, 1); PG8_STAGE(PG8_SB(1, 0), b3, voffB);
            PG8_BAR; PG8_WAIT_L(0); PG8_MMA(0, 1, At, B1); PG8_BAR;
            PG8_LDA(At, 1, 1); PG8_STAGE(PG8_SA(1, 0), a3, voffA);
            PG8_BAR; PG8_WAIT_L(0); PG8_MMA(1, 0, At, B0); PG8_BAR; PG8_SCHED;
            PG8_STAGE(PG8_SB(1, 1), b3 + hstep, voffB);
            PG8_WAIT_V(6); PG8_BAR; PG8_MMA(1, 1, At, B1); PG8_BAR;
            }
        }
        if constexpr (ALIGN_EPI) { if (wr == 0) PG8_BAR; }
        if constexpr (!Epi::AFTER_DRAIN) { E(acc, cur, wr, wc, fr, fq); S.done(cur); }
        if (!has_next) break;
#pragma unroll
        for (int a = 0; a < 2; ++a)
#pragma unroll
            for (int b = 0; b < 2; ++b)
#pragma unroll
                for (int m = 0; m < 4; ++m)
#pragma unroll
                    for (int n = 0; n < 2; ++n) acc[a][b][m][n] = (f32x4){0.f, 0.f, 0.f, 0.f};
        cur = nxt; cA = nA; cB = nB; ++ui;
        if constexpr (ALIGN_EPI) { if (wr == 1) PG8_BAR; }
    }
    PG8_WAIT_V(0);
    if constexpr (!ALIGN_EPI) { if (wr == 0) PG8_BAR; }
    PG8_BAR;
    if constexpr (Epi::AFTER_DRAIN) { E.fused(acc, cur, wr, wc, fr, fq, lds, wid, lane); S.done(cur); }
#undef PG8_SA
#undef PG8_SB
#undef PG8_STAGE
#undef PG8_LDA
#undef PG8_LDB
#undef PG8_MMA
#undef PG8_WAIT_V
#undef PG8_WAIT_L
#undef PG8_BAR
#undef PG8_SCHED
}
}
namespace mk {
using pg8::bf16_t; using pg8::bf16x8; using pg8::f32x4;
typedef float f32x16 __attribute__((ext_vector_type(16)));
typedef float f32x2 __attribute__((ext_vector_type(2)));
typedef unsigned u32x4 __attribute__((ext_vector_type(4)));
typedef unsigned u32x2 __attribute__((ext_vector_type(2)));
typedef short s16x4 __attribute__((ext_vector_type(4)));

constexpr int NB = 4, S = 4096, T = NB * S, D = 1024, L = 4, FF = 2816;
constexpr size_t MiB = 1u << 20;
constexpr size_t WS_MOD = 0, WS_WBF = 1 * MiB, WS_H = 44 * MiB, WS_ZF = 76 * MiB, WS_A = 76 * MiB, WS_Y = 76 * MiB, WS_QB = 108 * MiB, WS_KVB = 132 * MiB, WS_RT = 164 * MiB,
    WS_ZR = 204 * MiB, WS_CQN = 236 * MiB, WS_CKVN = 248 * MiB, WS_KPE = 256 * MiB, WS_DEC = 257 * MiB, WS_KKA = 289 * MiB, WS_KMOD = 321 * MiB, WS_KK = 353 * MiB,
    WS_RKV = 369 * MiB, WS_G = 417 * MiB, WS_KVT = 433 * MiB, WS_END = 449 * MiB, WS_VT = 172 * MiB, WS_CTR = 819200 + 16384;
constexpr size_t WB_W1A = 0, WB_W2A = 11534336, WB_W1B = 17301504, WB_W2B = 28835840, WB_WIN = 34603008, WB_WOUT = 40894464, WB_WUQ = 42991616, WB_WUKV = 43581440, WB_LWUP = 44105728, WB_LAUP = 44105728 + 65536, WB_LGUP = 44105728 + 131072;
constexpr int LDS_BYTES = 147456;
constexpr float LOG2E = 1.4426950408889634f, LOG2_1E4 = 13.287712379549449f;

struct Params { const void* in[29]; float* out; unsigned char* ws; };
typedef __attribute__((address_space(4))) const unsigned long long* karg_ptr;
__device__ __forceinline__ const void* kin(int i) { karg_ptr ka = (karg_ptr)__builtin_amdgcn_kernarg_segment_ptr(); asm volatile("" : "+s"(ka)); return (const void*)(__attribute__((address_space(1))) const void*)ka[i]; }
__device__ __forceinline__ float* kout() { return (float*)kin(29); }
__device__ __forceinline__ unsigned char* kws() { return (unsigned char*)kin(30); }
#define LAUNDER_V(x) asm volatile("" : "+v"(x))

__device__ __forceinline__ unsigned pk2(float lo, float hi) { return pg8::pk_bf16_rne(lo, hi); }
__device__ __forceinline__ float bf2f(unsigned short u) { return __uint_as_float(((unsigned)u) << 16); }
__device__ __forceinline__ float wave_sum(float v) {
#pragma unroll
    for (int o = 1; o < 64; o <<= 1) v += __shfl_xor(v, o);
    return v;
}
__device__ __forceinline__ float half_sum(float v) {
#pragma unroll
    for (int o = 1; o < 32; o <<= 1) v += __shfl_xor(v, o);
    return v;
}
__device__ __forceinline__ int crow(int r, int hi) { return (r & 3) + 8 * (r >> 2) + 4 * hi; }
#define MFMA32(a, b, c) __builtin_amdgcn_mfma_f32_32x32x16_bf16((a), (b), (c), 0, 0, 0)
#define LDSWAIT() asm volatile("s_waitcnt lgkmcnt(0)" ::: "memory")
__device__ __forceinline__ void sincos_rr(float ang, float& s, float& c) {
    const float k = rintf(ang * 0.15915494309189535f);
    float r = fmaf(-k, 6.2831854820251465f, ang);
    r = fmaf(-k, -1.7484556e-7f, r);
    s = __sinf(r); c = __cosf(r);
}
__device__ __forceinline__ float sigmoid_f(float x) { return 1.0f / (1.0f + expf(-x)); }

__device__ __forceinline__ void phase_mod(const Params& P, unsigned char* lds, int tid) {
    float* cond = (float*)lds; float* red = cond + 4096;
    const float* c = (const float*)kin(1); const float* w_ada = (const float*)kin(3); const float* b_ada = (const float*)kin(4);
    float* mod = (float*)(kws() + WS_MOD);
    for (int i = tid; i < 4096; i += 512) { const float v = c[i]; cond[i] = v / (1.0f + expf(-v)); }
    __syncthreads();
    const int ks = tid >> 4, cq = tid & 15;
    for (int item = blockIdx.x; item < 576; item += gridDim.x) {
        const int l = item / 144, n0 = (item % 144) * 64;
        const float* W = w_ada + (size_t)l * 1024 * 9216 + (size_t)(ks * 32) * 9216 + n0 + 4 * cq;
        f32x4 a0 = {0.f, 0.f, 0.f, 0.f}, a1 = a0, a2 = a0, a3 = a0;
        f32x4 wv[32];
#pragma unroll
        for (int k = 0; k < 32; ++k) wv[k] = *(const f32x4*)(W + (size_t)k * 9216);
#pragma unroll
        for (int k = 0; k < 32; ++k) { const int kk = ks * 32 + k; a0 += wv[k] * cond[kk]; a1 += wv[k] * cond[1024 + kk]; a2 += wv[k] * cond[2048 + kk]; a3 += wv[k] * cond[3072 + kk]; }
        *(f32x4*)(red + (ks * 4 + 0) * 64 + 4 * cq) = a0; *(f32x4*)(red + (ks * 4 + 1) * 64 + 4 * cq) = a1; *(f32x4*)(red + (ks * 4 + 2) * 64 + 4 * cq) = a2; *(f32x4*)(red + (ks * 4 + 3) * 64 + 4 * cq) = a3;
        __syncthreads();
        if (tid < 256) { const int b = tid >> 6, col = tid & 63; float sum = 0.f;
#pragma unroll
            for (int q = 0; q < 32; ++q) sum += red[(q * 4 + b) * 64 + col];
            mod[(size_t)(l * 4 + b) * 9216 + n0 + col] = sum + b_ada[l * 9216 + n0 + col]; }
        __syncthreads();
    }
}

__device__ __forceinline__ int srccol(int kind, int rho) {
    if (kind == 1) { const int G = rho >> 5, w = rho & 31; return w < 16 ? 16 * G + w : 2816 + 16 * G + (w - 16); }
    if (kind == 2) { return rho < 1824 ? rho : (rho < 2048 ? -1 : rho - 224); }
    return rho;
}
__device__ __forceinline__ void tr_item(const float* W, int K, int Nsrc, int Ndst, bf16_t* WT, int kind, float* scr, int item, int lane) {
    const int nblk = Ndst / 32, kb = item / nblk, nb = item % nblk, k0 = 64 * kb, n0 = 32 * nb;
    const int sc = srccol(kind, n0 + (lane & 31));
    float tv[32];
#pragma unroll
    for (int i = 0; i < 32; ++i) { const int kk = 2 * i + (lane >> 5); tv[i] = sc >= 0 ? W[(size_t)(k0 + kk) * Nsrc + sc] : 0.f; }
#pragma unroll
    for (int i = 0; i < 32; ++i) { const int kk = 2 * i + (lane >> 5); scr[kk * 33 + (lane & 31)] = tv[i]; }
    LDSWAIT();
    const int c = lane & 7;
#pragma unroll
    for (int j = 0; j < 4; ++j) { const int n = (lane >> 3) + 8 * j; const float* s = scr + (8 * c) * 33 + n;
        u32x4 o; o.x = pk2(s[0 * 33], s[1 * 33]); o.y = pk2(s[2 * 33], s[3 * 33]); o.z = pk2(s[4 * 33], s[5 * 33]); o.w = pk2(s[6 * 33], s[7 * 33]);
        *(u32x4*)(WT + (size_t)(n0 + n) * K + k0 + 8 * c) = o; }
    LDSWAIT();
}
__device__ __forceinline__ void convert_weights(const Params& P, int l, unsigned char* lds, int gw, int NGW, int wave, int lane) {
    float* scr = (float*)(lds + wave * 16384);
    unsigned char* wb = kws() + WS_WBF;
    constexpr int I_W1 = 16 * 176, I_W2 = 44 * 32, I_IN = 16 * 96, I_OUT = 16 * 32, I_UQ = 6 * 24, I_UKV = 4 * 32;
    constexpr int I_LO = 8, I_LG = 16;
    constexpr int NIT = 2 * I_W1 + 2 * I_W2 + I_IN + I_OUT + I_UQ + I_UKV + 4 * I_LO + I_LG;
    for (int it = gw; it < NIT; it += NGW) {
        int r = it;
        if (r < I_W1) { tr_item((const float*)kin(5) + (size_t)l * 1024 * 5632, 1024, 5632, 5632, (bf16_t*)(wb + WB_W1A), 1, scr, r, lane); continue; } r -= I_W1;
        if (r < I_W2) { tr_item((const float*)kin(6) + (size_t)l * 2816 * 1024, 2816, 1024, 1024, (bf16_t*)(wb + WB_W2A), 0, scr, r, lane); continue; } r -= I_W2;
        if (r < I_W1) { tr_item((const float*)kin(7) + (size_t)l * 1024 * 5632, 1024, 5632, 5632, (bf16_t*)(wb + WB_W1B), 1, scr, r, lane); continue; } r -= I_W1;
        if (r < I_W2) { tr_item((const float*)kin(8) + (size_t)l * 2816 * 1024, 2816, 1024, 1024, (bf16_t*)(wb + WB_W2B), 0, scr, r, lane); continue; } r -= I_W2;
        if (r < I_IN) { tr_item((const float*)kin(9) + (size_t)l * 1024 * 2848, 1024, 2848, 3072, (bf16_t*)(wb + WB_WIN), 2, scr, r, lane); continue; } r -= I_IN;
        if (r < I_OUT) { tr_item((const float*)kin(10) + (size_t)l * 1024 * 1024, 1024, 1024, 1024, (bf16_t*)(wb + WB_WOUT), 0, scr, r, lane); continue; } r -= I_OUT;
        if (r < I_UQ) { tr_item((const float*)kin(23) + (size_t)l * 384 * 768, 384, 768, 768, (bf16_t*)(wb + WB_WUQ), 0, scr, r, lane); continue; } r -= I_UQ;
        if (r < I_UKV) { tr_item((const float*)kin(25) + (size_t)l * 256 * 1024, 256, 1024, 1024, (bf16_t*)(wb + WB_WUKV), 0, scr, r, lane); continue; } r -= I_UKV;
        if (r < 2 * I_LO) { const int d = r / I_LO; tr_item((const float*)kin(13) + (size_t)(l * 2 + d) * 64 * 256, 64, 256, 256, (bf16_t*)(wb + WB_LWUP) + d * 256 * 64, 0, scr, r % I_LO, lane); continue; } r -= 2 * I_LO;
        if (r < 2 * I_LO) { const int d = r / I_LO; tr_item((const float*)kin(15) + (size_t)(l * 2 + d) * 64 * 256, 64, 256, 256, (bf16_t*)(wb + WB_LAUP) + d * 256 * 64, 0, scr, r % I_LO, lane); continue; } r -= 2 * I_LO;
        tr_item((const float*)kin(16) + (size_t)l * 128 * 256, 128, 256, 256, (bf16_t*)(wb + WB_LGUP), 0, scr, r, lane);
    }
}

__device__ __forceinline__ void norm_rows(const Params& P, const float* src, float* copy_dst, int l, int shi, int gw, int NGW, int lane) {
    const float* modl = (const float*)(kws() + WS_MOD) + (size_t)l * 4 * 9216;
    bf16_t* H = (bf16_t*)(kws() + WS_H);
    for (int m0 = 2 * gw; m0 < T; m0 += 2 * NGW) {
        f32x4 v[2][4]; float s[2] = {0.f, 0.f};
#pragma unroll
        for (int q = 0; q < 2; ++q) { const f32x4* xr = (const f32x4*)(src + (size_t)(m0 + q) * D) + lane;
#pragma unroll
            for (int j = 0; j < 4; ++j) v[q][j] = xr[64 * j]; }
#pragma unroll
        for (int q = 0; q < 2; ++q) {
#pragma unroll
            for (int j = 0; j < 4; ++j) s[q] += (v[q][j].x * v[q][j].x + v[q][j].y * v[q][j].y) + (v[q][j].z * v[q][j].z + v[q][j].w * v[q][j].w); }
#pragma unroll
        for (int q = 0; q < 2; ++q) {
            const int m = m0 + q, b = m >> 12;
            const float rstd = 1.0f / sqrtf(wave_sum(s[q]) * (1.0f / D) + 1e-6f);
            const f32x4* sh = (const f32x4*)(modl + (size_t)b * 9216 + shi * 1024) + lane;
            const f32x4* sc = (const f32x4*)(modl + (size_t)b * 9216 + (shi + 1) * 1024) + lane;
            u32x2* o8 = (u32x2*)(H + (size_t)m * D) + lane;
#pragma unroll
            for (int j = 0; j < 4; ++j) { const f32x4 a = sh[64 * j], c = sc[64 * j]; const f32x4 o = v[q][j] * rstd * (c + 1.0f) + a;
                u32x2 w; w.x = pk2(o.x, o.y); w.y = pk2(o.z, o.w); o8[64 * j] = w; }
            if (copy_dst) { f32x4* cd = (f32x4*)(copy_dst + (size_t)m * D) + lane;
#pragma unroll
                for (int j = 0; j < 4; ++j) cd[64 * j] = v[q][j]; }
        }
    }
}
__device__ __forceinline__ void final_norm(const Params& P, int gw, int NGW, int lane) {
    const float* g = (const float*)kin(28);
    for (int m0 = 2 * gw; m0 < T; m0 += 2 * NGW) {
        f32x4 v[2][4]; float s[2] = {0.f, 0.f};
#pragma unroll
        for (int q = 0; q < 2; ++q) { const f32x4* xr = (const f32x4*)(kout() + (size_t)(m0 + q) * D) + lane;
#pragma unroll
            for (int j = 0; j < 4; ++j) v[q][j] = xr[64 * j]; }
#pragma unroll
        for (int q = 0; q < 2; ++q) {
#pragma unroll
            for (int j = 0; j < 4; ++j) s[q] += (v[q][j].x * v[q][j].x + v[q][j].y * v[q][j].y) + (v[q][j].z * v[q][j].z + v[q][j].w * v[q][j].w); }
#pragma unroll
        for (int q = 0; q < 2; ++q) {
            f32x4* xr = (f32x4*)(kout() + (size_t)(m0 + q) * D) + lane;
            const float rstd = 1.0f / sqrtf(wave_sum(s[q]) * (1.0f / D) + 1e-6f);
#pragma unroll
            for (int j = 0; j < 4; ++j) { const f32x4 gg = ((const f32x4*)g)[lane + 64 * j]; xr[64 * j] = v[q][j] * rstd * gg; }
        }
    }
}

constexpr int ZL = 392;
__device__ __forceinline__ void rwkv_prep(const Params& P, int l, unsigned char* lds, int tid) {
    bf16_t* zl = (bf16_t*)lds;
    float* kl = (float*)(lds + 64 * ZL * 2);
    const float* ZF = (const float*)(kws() + WS_ZF);
    float* RKV = (float*)(kws() + WS_RKV); float* DEC = (float*)(kws() + WS_DEC); float* KKA = (float*)(kws() + WS_KKA); float* KMOD = (float*)(kws() + WS_KMOD);
    float* KK = (float*)(kws() + WS_KK); float* G = (float*)(kws() + WS_G);
    const float* mu = (const float*)kin(11) + l * 1152;
    const float* w0 = (const float*)kin(12) + l * 512; const float* a0 = (const float*)kin(14) + l * 512;
    const float* k_k = (const float*)kin(17) + l * 256; const float* k_a = (const float*)kin(18) + l * 256;
    const bf16_t* WUP = (const bf16_t*)(kws() + WS_WBF + WB_LWUP); const bf16_t* AUP = (const bf16_t*)(kws() + WS_WBF + WB_LAUP); const bf16_t* GUP = (const bf16_t*)(kws() + WS_WBF + WB_LGUP);
    for (int tile = blockIdx.x; tile < T / 64; tile += gridDim.x) {
        LAUNDER_V(tid);
        const int lane = tid & 63, wid = tid >> 6, r32 = lane & 31, hi = lane >> 5, h = wid & 3, th = wid >> 2;
        const int t0 = tile * 64, s0 = t0 & (S - 1);
#pragma unroll 4
        for (int idx = tid; idx < 64 * 288; idx += 512) {
            const int row = idx / 288, c4 = idx % 288, t = t0 + row, s = s0 + row;
            const f32x4 z = *(const f32x4*)(ZF + (size_t)t * 2048 + 4 * c4);
            f32x4 pv = {0.f, 0.f, 0.f, 0.f}, nx = {0.f, 0.f, 0.f, 0.f};
            if (s > 0) pv = *(const f32x4*)(ZF + (size_t)(t - 1) * 2048 + 4 * c4);
            if (s < S - 1) nx = *(const f32x4*)(ZF + (size_t)(t + 1) * 2048 + 4 * c4);
            const f32x4 m4 = *(const f32x4*)(mu + 4 * c4);
            f32x4 v = z + m4 * ((pv + nx) * 0.5f - z);
            const int col = 4 * c4;
            if (col < 768) {
                *(f32x4*)(RKV + (size_t)t * 768 + col) = v;
                if (col >= 256 && col < 512) *(f32x4*)(kl + row * 256 + (col - 256)) = v;
            } else {
                if (col < 896) { v.x = sigmoid_f(v.x); v.y = sigmoid_f(v.y); v.z = sigmoid_f(v.z); v.w = sigmoid_f(v.w); }
                else if (col < 1024) { v.x = tanhf(v.x); v.y = tanhf(v.y); v.z = tanhf(v.z); v.w = tanhf(v.w); }
                u32x2 w; w.x = pk2(v.x, v.y); w.y = pk2(v.z, v.w);
                *(u32x2*)(zl + row * ZL + (col - 768)) = w;
            }
        }
        __syncthreads();
        const bf16_t* za = zl + (32 * th + r32) * ZL + 8 * hi;
        const int cA = h * 64 + r32;
        float kinv[16];
        const float kk_c0 = k_k[cA], kk_c1 = k_k[cA + 32];
#pragma unroll
        for (int r = 0; r < 16; ++r) { const int tok = 32 * th + crow(r, hi); const float x0 = kl[tok * 256 + cA] * kk_c0, x1 = kl[tok * 256 + cA + 32] * kk_c1;
            const float nrm = sqrtf(half_sum(x0 * x0 + x1 * x1)); kinv[r] = 1.0f / fmaxf(nrm, 1e-12f);
            const unsigned t = (unsigned)(t0 + tok); KK[t * 256 + cA] = x0 * kinv[r]; KK[t * 256 + cA + 32] = x1 * kinv[r]; __builtin_amdgcn_sched_barrier(0); }
        const float ka0 = k_a[cA], ka1 = k_a[cA + 32];
#pragma unroll 1
        for (int d = 0; d < 2; ++d) {
            int dl = d; asm volatile("" : "+s"(dl));
            int t0l = t0; asm volatile("" : "+s"(t0l));
            { f32x16 c0, c1;
#pragma unroll
              for (int i = 0; i < 16; ++i) { c0[i] = 0.f; c1[i] = 0.f; }
              const bf16_t* wt = WUP + (size_t)dl * 256 * 64;
#pragma unroll
              for (int s = 0; s < 4; ++s) { const bf16x8 a = *(const bf16x8*)(za + 128 + dl * 64 + 16 * s);
                  const bf16x8 b0 = *(const bf16x8*)(wt + (size_t)cA * 64 + 16 * s + 8 * hi), b1 = *(const bf16x8*)(wt + (size_t)(cA + 32) * 64 + 16 * s + 8 * hi);
                  c0 = MFMA32(a, b0, c0); c1 = MFMA32(a, b1, c1); }
              const float wb0 = w0[dl * 256 + cA], wb1 = w0[dl * 256 + cA + 32];
#pragma unroll
              for (int r = 0; r < 16; ++r) { const unsigned t = (unsigned)(dl * T + t0l + 32 * th + crow(r, hi));
                  DEC[t * 256 + cA] = expf(-0.6065306597126334f * sigmoid_f(wb0 + c0[r])); DEC[t * 256 + cA + 32] = expf(-0.6065306597126334f * sigmoid_f(wb1 + c1[r])); __builtin_amdgcn_sched_barrier(0); } }
            { f32x16 c0, c1;
#pragma unroll
              for (int i = 0; i < 16; ++i) { c0[i] = 0.f; c1[i] = 0.f; }
              const bf16_t* wt = AUP + (size_t)dl * 256 * 64;
#pragma unroll
              for (int s = 0; s < 4; ++s) { const bf16x8 a = *(const bf16x8*)(za + 256 + dl * 64 + 16 * s);
                  const bf16x8 b0 = *(const bf16x8*)(wt + (size_t)cA * 64 + 16 * s + 8 * hi), b1 = *(const bf16x8*)(wt + (size_t)(cA + 32) * 64 + 16 * s + 8 * hi);
                  c0 = MFMA32(a, b0, c0); c1 = MFMA32(a, b1, c1); }
              const float ab0 = a0[dl * 256 + cA], ab1 = a0[dl * 256 + cA + 32];
#pragma unroll
              for (int r = 0; r < 16; ++r) { const unsigned t = (unsigned)(dl * T + t0l + 32 * th + crow(r, hi));
                  const float ad0 = sigmoid_f(ab0 + c0[r]), ad1 = sigmoid_f(ab1 + c1[r]);
                  const int tok = 32 * th + crow(r, hi); const float kq0 = kl[tok * 256 + cA], kq1 = kl[tok * 256 + cA + 32];
                  KKA[t * 256 + cA] = -(kq0 * kk_c0 * kinv[r] * ad0); KKA[t * 256 + cA + 32] = -(kq1 * kk_c1 * kinv[r] * ad1);
                  KMOD[t * 256 + cA] = kq0 * (1.0f + (ad0 - 1.0f) * ka0); KMOD[t * 256 + cA + 32] = kq1 * (1.0f + (ad1 - 1.0f) * ka1); __builtin_amdgcn_sched_barrier(0); } }
        }
        { f32x16 c0, c1;
#pragma unroll
          for (int i = 0; i < 16; ++i) { c0[i] = 0.f; c1[i] = 0.f; }
#pragma unroll
          for (int s = 0; s < 8; ++s) { const bf16x8 a = *(const bf16x8*)(za + 16 * s);
              const bf16x8 b0 = *(const bf16x8*)(GUP + (size_t)cA * 128 + 16 * s + 8 * hi), b1 = *(const bf16x8*)(GUP + (size_t)(cA + 32) * 128 + 16 * s + 8 * hi);
              c0 = MFMA32(a, b0, c0); c1 = MFMA32(a, b1, c1); }
#pragma unroll
          for (int r = 0; r < 16; ++r) { const unsigned t = (unsigned)(t0 + 32 * th + crow(r, hi)); G[t * 256 + cA] = c0[r]; G[t * 256 + cA + 32] = c1[r]; __builtin_amdgcn_sched_barrier(0); } }
        __syncthreads();
    }
}

__device__ __forceinline__ void mla_prep(const Params& P, int l, int gw, int NGW, int lane) {
    const float* ZF = (const float*)(kws() + WS_ZF); const int* pos = (const int*)kin(2);
    bf16_t* CQN = (bf16_t*)(kws() + WS_CQN); bf16_t* CKVN = (bf16_t*)(kws() + WS_CKVN); bf16_t* KPE = (bf16_t*)(kws() + WS_KPE);
    const float* qg = (const float*)kin(22) + l * 384; const float* kg = (const float*)kin(24) + l * 256;
    for (int mm = 2 * gw; mm < T; mm += 2 * NGW) {
        float q[2][6], kv[2][4], t1[2], t2[2]; int ps[2];
#pragma unroll
        for (int u = 0; u < 2; ++u) { const float* row = ZF + (size_t)(mm + u) * 2048;
#pragma unroll
            for (int j = 0; j < 6; ++j) q[u][j] = row[1152 + lane + 64 * j];
#pragma unroll
            for (int j = 0; j < 4; ++j) kv[u][j] = row[1536 + lane + 64 * j];
            t1[u] = row[1792 + (lane & 15)]; t2[u] = row[1808 + (lane & 15)]; ps[u] = pos[mm + u]; }
#pragma unroll
        for (int u = 0; u < 2; ++u) {
            const int m = mm + u;
            float s = 0.f;
#pragma unroll
            for (int j = 0; j < 6; ++j) s += q[u][j] * q[u][j];
            float rstd = 1.0f / sqrtf(wave_sum(s) * (1.0f / 384.0f) + 1e-6f);
#pragma unroll
            for (int j = 0; j < 6; ++j) CQN[(size_t)m * 384 + lane + 64 * j] = (bf16_t)(pk2(q[u][j] * rstd * qg[lane + 64 * j], 0.f) & 0xffffu);
            s = 0.f;
#pragma unroll
            for (int j = 0; j < 4; ++j) s += kv[u][j] * kv[u][j];
            rstd = 1.0f / sqrtf(wave_sum(s) * (1.0f / 256.0f) + 1e-6f);
#pragma unroll
            for (int j = 0; j < 4; ++j) CKVN[(size_t)m * 256 + lane + 64 * j] = (bf16_t)(pk2(kv[u][j] * rstd * kg[lane + 64 * j], 0.f) & 0xffffu);
            if (lane < 16) {
                const float inv = exp2f(-(float)lane * (LOG2_1E4 / 16.0f));
                float sn, cs; sincos_rr((float)ps[u] * inv, sn, cs);
                KPE[(size_t)m * 32 + lane] = (bf16_t)(pk2(t1[u] * cs - t2[u] * sn, 0.f) & 0xffffu);
                KPE[(size_t)m * 32 + 16 + lane] = (bf16_t)(pk2(t2[u] * cs + t1[u] * sn, 0.f) & 0xffffu);
            }
        }
    }
}

constexpr int RS = 136;
__device__ __forceinline__ void ret_state(const Params& P, int l, unsigned char* lds, int tid) {
    bf16_t* Ktf = (bf16_t*)lds; bf16_t* Ktb = Ktf + 64 * RS; bf16_t* Vt = Ktb + 64 * RS;
    bf16_t* ZR = (bf16_t*)(kws() + WS_ZR); float* KVT = (float*)(kws() + WS_KVT);
    const int* pos = (const int*)kin(2); const float* lr = (const float*)kin(26) + l * 8;
    for (int u = blockIdx.x; u < 512; u += gridDim.x) {
        LAUNDER_V(tid);
        const int lane = tid & 63, wid = tid >> 6, r32 = lane & 31, hi = lane >> 5;
        const int b = u >> 7, h = (u >> 5) & 3, n = u & 31;
        const float lgf2 = -expf(lr[h]) * LOG2E, lgb2 = -expf(lr[4 + h]) * LOG2E;
        const size_t t0 = (size_t)b * S + n * 128;
        {
            const int c = tid & 127, i8 = tid >> 7;
            bf16_t* row = ZR + (t0 + c) * 1024 + h * 64;
            const u32x4 qlo = *(const u32x4*)(row + 8 * i8), qhi = *(const u32x4*)(row + 32 + 8 * i8);
            const u32x4 klo = *(const u32x4*)(row + 256 + 8 * i8), khi = *(const u32x4*)(row + 256 + 32 + 8 * i8);
            const float p = (float)pos[t0 + c];
            const float wf = exp2f(lgf2 * (float)(127 - c)), wb = exp2f(lgb2 * (float)c);
            u32x4 oql, oqh, okl, okh;
#pragma unroll
            for (int jj = 0; jj < 4; ++jj) {
                float ql[2], qh[2], kl[2], kh[2], nql[2], nqh[2], nkl[2], nkh[2];
                ql[0] = bf2f((unsigned short)(qlo[jj] & 0xffffu)); ql[1] = bf2f((unsigned short)(qlo[jj] >> 16));
                qh[0] = bf2f((unsigned short)(qhi[jj] & 0xffffu)); qh[1] = bf2f((unsigned short)(qhi[jj] >> 16));
                kl[0] = bf2f((unsigned short)(klo[jj] & 0xffffu)); kl[1] = bf2f((unsigned short)(klo[jj] >> 16));
                kh[0] = bf2f((unsigned short)(khi[jj] & 0xffffu)); kh[1] = bf2f((unsigned short)(khi[jj] >> 16));
#pragma unroll
                for (int e = 0; e < 2; ++e) {
                    const int i = 8 * i8 + 2 * jj + e;
                    const float inv = exp2f(-(float)i * (LOG2_1E4 / 32.0f));
                    float sn, cs; sincos_rr(p * inv, sn, cs);
                    nql[e] = ql[e] * cs - qh[e] * sn; nqh[e] = qh[e] * cs + ql[e] * sn;
                    nkl[e] = (kl[e] * cs - kh[e] * sn) * 0.125f; nkh[e] = (kh[e] * cs + kl[e] * sn) * 0.125f;
                    Ktf[i * RS + c] = (bf16_t)(pk2(nkl[e] * wf, 0.f) & 0xffffu); Ktf[(32 + i) * RS + c] = (bf16_t)(pk2(nkh[e] * wf, 0.f) & 0xffffu);
                    Ktb[i * RS + c] = (bf16_t)(pk2(nkl[e] * wb, 0.f) & 0xffffu); Ktb[(32 + i) * RS + c] = (bf16_t)(pk2(nkh[e] * wb, 0.f) & 0xffffu);
                }
                oql[jj] = pk2(nql[0], nql[1]); oqh[jj] = pk2(nqh[0], nqh[1]); okl[jj] = pk2(nkl[0], nkl[1]); okh[jj] = pk2(nkh[0], nkh[1]);
            }
            *(u32x4*)(row + 8 * i8) = oql; *(u32x4*)(row + 32 + 8 * i8) = oqh; *(u32x4*)(row + 256 + 8 * i8) = okl; *(u32x4*)(row + 256 + 32 + 8 * i8) = okh;
#pragma unroll
            for (int it = 0; it < 2; ++it) {
                const int idx = tid + 512 * it, key = idx & 127, e8 = (idx >> 7) * 8;
                const u32x4 v = *(const u32x4*)(ZR + (t0 + key) * 1024 + 512 + h * 64 + e8);
#pragma unroll
                for (int i = 0; i < 8; ++i) Vt[(e8 + i) * RS + key] = (bf16_t)((v[i >> 1] >> (16 * (i & 1))) & 0xffffu);
            }
        }
        __syncthreads();
        {
            const int dir = wid >> 2, eb = (wid >> 1) & 1, db = wid & 1;
            const bf16_t* Kw = dir ? Ktb : Ktf;
            f32x16 acc;
#pragma unroll
            for (int i = 0; i < 16; ++i) acc[i] = 0.f;
#pragma unroll
            for (int s = 0; s < 8; ++s) {
                const bf16x8 a = *(const bf16x8*)(Vt + (32 * eb + r32) * RS + 16 * s + 8 * hi);
                const bf16x8 bb = *(const bf16x8*)(Kw + (32 * db + r32) * RS + 16 * s + 8 * hi);
                acc = MFMA32(a, bb, acc);
            }
            float* o = KVT + ((size_t)u * 2 + dir) * 4096;
#pragma unroll
            for (int r = 0; r < 16; ++r) o[(32 * eb + crow(r, hi)) * 64 + 32 * db + r32] = acc[r];
        }
        __syncthreads();
    }
}
__device__ __forceinline__ void ret_scan(const Params& P, int l, int tid) {
    const float* KVT = (const float*)(kws() + WS_KVT); bf16_t* RT = (bf16_t*)(kws() + WS_RT);
    const float* lr = (const float*)kin(26) + l * 8;
    for (int g = blockIdx.x * 512 + tid; g < 16 * 2 * 4096; g += gridDim.x * 512) {
        const int idx = g & 4095, dir = (g >> 12) & 1, bh = g >> 13, h = bh & 3;
        const float dc = expf(-expf(lr[dir * 4 + h]) * 128.0f);
        float kv[32];
#pragma unroll
        for (int n = 0; n < 32; ++n) kv[n] = KVT[((size_t)(bh * 32 + n) * 2 + dir) * 4096 + idx];
        float R = 0.f;
        if (dir == 0) {
#pragma unroll
            for (int n = 0; n < 32; ++n) { const size_t o = ((size_t)(bh * 32 + n) * 2 + 0) * 4096 + idx; RT[o] = (bf16_t)(pk2(R, 0.f) & 0xffffu); R = R * dc + kv[n]; } }
        else {
#pragma unroll
            for (int n = 31; n >= 0; --n) { const size_t o = ((size_t)(bh * 32 + n) * 2 + 1) * 4096 + idx; RT[o] = (bf16_t)(pk2(R, 0.f) & 0xffffu); R = R * dc + kv[n]; } }
    }
}

template <int CTRL> __device__ __forceinline__ float dpp_add(float x) { const int y = __builtin_amdgcn_update_dpp(0, __float_as_int(x), CTRL, 0xf, 0xf, false); return x + __int_as_float(y); }
__device__ __forceinline__ float row16_sum(float x) { x = dpp_add<0x128>(x); x = dpp_add<0x124>(x); x = dpp_add<0x122>(x); x = dpp_add<0x121>(x); return x; }
constexpr int SC_CH = 16, SC_BUF = SC_CH * (5 * 64 + 16), SC_YP = SC_CH * 64, SC_NB = 5;
template <int DIR> __device__ __forceinline__ void rwkv_scan_dir(const Params& P, unsigned char* lds, int sb, int tid) {
    float* buf = (float*)lds;
    float* ypart = buf + SC_NB * SC_BUF + 1024;
    const float* DEC = (const float*)(kws() + WS_DEC) + (size_t)DIR * T * 256; const float* KKA = (const float*)(kws() + WS_KKA) + (size_t)DIR * T * 256;
    const float* KMOD = (const float*)(kws() + WS_KMOD) + (size_t)DIR * T * 256; const float* KK = (const float*)(kws() + WS_KK); const float* RKV = (const float*)(kws() + WS_RKV);
    float* Y = (float*)(kws() + WS_Y) + (size_t)DIR * T * 256;
    const int chain = sb >> 2, rq = sb & 3, b = (chain >> 2) & 3, h = chain & 3;
    const int cbase = h * 64;
    const size_t row0 = (size_t)b * S;
    const int wid = tid >> 6, lane = tid & 63;
    const bool loader = wid >= 4;
    const int grp = wid - 4;
    const int ltid = tid - 256;
    f32x4 lr_[20], lv;
#define SC_LOAD(ck) do { _Pragma("unroll") for (int i = 0; i < 20; ++i) { const int wi = lane + 64 * (i & 3), st = wi >> 4, q4 = wi & 15; const int s = (ck) * SC_CH + st; const size_t gr = row0 + (DIR ? (S - 1 - s) : s); \
        const float* src_ = (i >> 2) == 0 ? DEC + gr * 256 : (i >> 2) == 1 ? KK + gr * 256 : (i >> 2) == 2 ? KKA + gr * 256 : (i >> 2) == 3 ? KMOD + gr * 256 : RKV + gr * 768; \
        lr_[i] = *(const f32x4*)(src_ + cbase + 4 * q4); } \
        { const int st = lane >> 2, q4 = lane & 3; const int s = (ck) * SC_CH + st; const size_t gr = row0 + (DIR ? (S - 1 - s) : s); lv = *(const f32x4*)(RKV + gr * 768 + 512 + cbase + rq * 16 + 4 * q4); } } while (0)
#define SC_STORE(ck) do { float* B_ = buf + ((ck) % SC_NB) * SC_BUF; _Pragma("unroll") for (int i = 0; i < 20; ++i) { const int wi = lane + 64 * (i & 3), st = wi >> 4, q4 = wi & 15; \
        *(f32x4*)(B_ + st * 336 + (i >> 2) * 64 + 4 * q4) = lr_[i]; } \
        { const int st = lane >> 2, q4 = lane & 3; *(f32x4*)(B_ + st * 336 + 320 + 4 * q4) = lv; } } while (0)
#define SC_YOUT(ck) do { const float* yp_ = ypart + ((ck) & 1) * SC_YP; const int st = ltid >> 4, rw = ltid & 15; \
        const f32x4 q_ = *(const f32x4*)(yp_ + ltid * 4); const int s = (ck) * SC_CH + st; const size_t gr = row0 + (DIR ? (S - 1 - s) : s); \
        Y[gr * 256 + cbase + rq * 16 + rw] = (q_.x + q_.y) + (q_.z + q_.w); } while (0)
    constexpr int NCH = S / SC_CH;
    if (loader) { SC_LOAD(grp); if (grp == 0) { SC_STORE(0); SC_LOAD(4); } }
    __syncthreads();
    const int rowi = (wid & 3) * 4 + (lane >> 4), j = lane & 15;
    f32x2 sA = {0.f, 0.f}, sB = {0.f, 0.f};
    for (int ck = 0; ck < NCH; ++ck) {
        if (loader) {
            if (ck + 1 < NCH && ((ck + 1) & 3) == grp) { SC_STORE(ck + 1); if (ck + 5 < NCH) SC_LOAD(ck + 5); }
            if (ck > 0) SC_YOUT(ck - 1);
        } else {
            const float* rp = buf + (ck % SC_NB) * SC_BUF + 4 * j;
            const float* vp = buf + (ck % SC_NB) * SC_BUF + 320 + rowi;
            int yoff = (ck & 1) * SC_YP + rowi * 4 + (j & 3); LAUNDER_V(yoff);
            float* yp = ypart + yoff;
            f32x4 w = *(const f32x4*)(rp), kk = *(const f32x4*)(rp + 64), kka = *(const f32x4*)(rp + 128), km = *(const f32x4*)(rp + 192), r = *(const f32x4*)(rp + 256);
            float v = *vp;
            f32x4 w1 = *(const f32x4*)(rp + 336), kk1 = *(const f32x4*)(rp + 336 + 64), kka1 = *(const f32x4*)(rp + 336 + 128), km1 = *(const f32x4*)(rp + 336 + 192), r1 = *(const f32x4*)(rp + 336 + 256);
            float v1 = vp[336];
#define LO2(x) __builtin_shufflevector(x, x, 0, 1)
#define HI2(x) __builtin_shufflevector(x, x, 2, 3)
#pragma unroll 8
            for (int st = 0; st < SC_CH; ++st) {
                const float* rn = rp + (st + 2) * 336;
                const f32x4 nw = *(const f32x4*)(rn), nkk = *(const f32x4*)(rn + 64), nkka = *(const f32x4*)(rn + 128), nkm = *(const f32x4*)(rn + 192), nr = *(const f32x4*)(rn + 256);
                const float nv = vp[(st + 2) * 336];
                f32x2 q = sA * LO2(kk); q = sB * HI2(kk) + q;
                float sk = q.x + q.y;
                float yy = 0.f;
                if (DIR == 1) { f32x2 yq = sA * LO2(r); yq = sB * HI2(r) + yq; yy = yq.x + yq.y; }
                sk = row16_sum(sk);
                f32x2 tA = LO2(km) * v, tB = HI2(km) * v;
                tA = sA * LO2(w) + tA; tB = sB * HI2(w) + tB;
                sA = LO2(kka) * sk + tA; sB = HI2(kka) * sk + tB;
                if (DIR == 0) { f32x2 yq = sA * LO2(r); yq = sB * HI2(r) + yq; yy = yq.x + yq.y; }
                yy = dpp_add<0x128>(yy); yy = dpp_add<0x124>(yy);
                yp[st * 64] = yy;
                w = w1; kk = kk1; kka = kka1; km = km1; r = r1; v = v1;
                w1 = nw; kk1 = nkk; kka1 = nkka; km1 = nkm; r1 = nr; v1 = nv;
            }
#undef LO2
#undef HI2
        }
        asm volatile("s_waitcnt lgkmcnt(0)\n\ts_barrier" ::: "memory");
    }
    if (loader) SC_YOUT(NCH - 1);
    __syncthreads();
#undef SC_LOAD
#undef SC_STORE
#undef SC_YOUT
}

__device__ __forceinline__ void rwkv_post(const Params& P, int l, int gw, int NGW, int lane) {
    const float* Y = (const float*)(kws() + WS_Y); const float* RKV = (const float*)(kws() + WS_RKV); const float* G = (const float*)(kws() + WS_G);
    bf16_t* MIX = (bf16_t*)(kws() + WS_H);
    const float* r_k = (const float*)kin(19) + l * 256; const float* ln_g = (const float*)kin(20) + l * 256; const float* ln_b = (const float*)kin(21) + l * 256;
    for (int it0 = gw; it0 < T * 4; it0 += 4 * NGW) {
        float y[4], r[4], k[4], v[4], g[4], lg[4], lb[4], rk[4];
#pragma unroll
        for (int q = 0; q < 4; ++q) { const int it = it0 + q * NGW; const size_t t = (size_t)(it >> 2); const int c = (it & 3) * 64 + lane;
            y[q] = Y[t * 256 + c] + Y[((size_t)T + t) * 256 + c]; r[q] = RKV[t * 768 + c]; k[q] = RKV[t * 768 + 256 + c]; v[q] = RKV[t * 768 + 512 + c]; g[q] = G[t * 256 + c];
            lg[q] = ln_g[c]; lb[q] = ln_b[c]; rk[q] = r_k[c]; }
#pragma unroll
        for (int q = 0; q < 4; ++q) { const int it = it0 + q * NGW; const size_t t = (size_t)(it >> 2); const int c = (it & 3) * 64 + lane;
            const float mean = wave_sum(y[q]) * (1.0f / 64.0f);
            const float dd = y[q] - mean;
            const float var = wave_sum(dd * dd) * (1.0f / 64.0f);
            const float yn = dd * (1.0f / sqrtf(var + 64e-5f)) * lg[q] + lb[q];
            const float bonus = wave_sum(r[q] * k[q] * rk[q]) * v[q];
            MIX[t * 1024 + c] = (bf16_t)(pk2((yn + bonus) * g[q], 0.f) & 0xffffu); }
    }
}

constexpr int AK = 104, AV = 72;
constexpr int AT_KB = 64 * AK * 2, AT_VB = 64 * AV * 2;
__device__ __forceinline__ float max3_asm(float a, float b, float c) { float r; asm("v_max3_f32 %0, %1, %2, %3" : "=v"(r) : "v"(a), "v"(b), "v"(c)); return r; }
__device__ __forceinline__ float max2_asm(float a, float b) { float r; asm("v_max_f32_e32 %0, %1, %2" : "=v"(r) : "v"(a), "v"(b)); return r; }
__device__ __forceinline__ float halves_max(float m) { auto rr = __builtin_amdgcn_permlane32_swap(__float_as_uint(m), __float_as_uint(m), false, false); return max2_asm(__uint_as_float(rr[0]), __uint_as_float(rr[1])); }
constexpr float ATT_THR = 12.0f;
__device__ __forceinline__ void attn_unit(const Params& P, unsigned char* lds, int b, int h, int qb, int tid) {
    const int lane = tid & 63, r32 = lane & 31, hi = lane >> 5, wid = tid >> 6;
    float* wsf = (float*)(lds + 2 * AT_KB + 2 * AT_VB) + wid * 64;
    const bf16_t* QB = (const bf16_t*)(kws() + WS_QB); const bf16_t* KVB = (const bf16_t*)(kws() + WS_KVB); const bf16_t* KPE = (const bf16_t*)(kws() + WS_KPE);
    const bf16_t* VTg = (const bf16_t*)(kws() + WS_VT) + (size_t)((b * 8 + h) * 64) * 4096;
    bf16_t* MIX = (bf16_t*)(kws() + WS_H); const int* pos = (const int*)kin(2);
    const size_t row0 = (size_t)b * S;
    const int q0 = qb * 256 + wid * 32;
    bf16x8 qr[6];
    {
        const size_t qrow = row0 + q0 + r32;
        float qf[6][8];
#pragma unroll
        for (int s = 0; s < 6; ++s) { const bf16x8 raw = *(const bf16x8*)(QB + qrow * 768 + h * 96 + 16 * s + 8 * hi);
#pragma unroll
            for (int j = 0; j < 8; ++j) qf[s][j] = bf2f((unsigned short)raw[j]); }
        const float p = (float)pos[qrow];
#pragma unroll
        for (int j = 0; j < 8; ++j) { const float inv = exp2f(-(float)(8 * hi + j) * (LOG2_1E4 / 16.0f)); float sn, cs; sincos_rr(p * inv, sn, cs);
            const float t1 = qf[4][j], t2 = qf[5][j]; qf[4][j] = t1 * cs - t2 * sn; qf[5][j] = t2 * cs + t1 * sn; }
        const float C2 = 0.10206207261596577f * LOG2E;
#pragma unroll
        for (int s = 0; s < 6; ++s) { u32x4 w; w.x = pk2(qf[s][0] * C2, qf[s][1] * C2); w.y = pk2(qf[s][2] * C2, qf[s][3] * C2); w.z = pk2(qf[s][4] * C2, qf[s][5] * C2); w.w = pk2(qf[s][6] * C2, qf[s][7] * C2);
            qr[s] = __builtin_bit_cast(bf16x8, w); }
    }
    const int key0 = tid / 12, part0 = tid % 12, key1 = (512 + tid) / 12, part1 = (512 + tid) % 12;
    const int ve = tid >> 3, vpart = tid & 7;
    u32x4 kA, kB = {0u, 0u, 0u, 0u}, vR;
    const bf16_t* kp0 = part0 < 8 ? KVB + (row0 + key0) * 1024 + h * 128 + part0 * 8 : KPE + (row0 + key0) * 32 + (part0 - 8) * 8;
    const bf16_t* kp1 = part1 < 8 ? KVB + (row0 + key1) * 1024 + h * 128 + part1 * 8 : KPE + (row0 + key1) * 32 + (part1 - 8) * 8;
    const int ks0 = part0 < 8 ? 64 * 1024 : 64 * 32, ks1 = part1 < 8 ? 64 * 1024 : 64 * 32;
    const bf16_t* vp0 = VTg + (size_t)ve * 4096 + vpart * 8;
#define AT_LOADK(kt) do { kA = *(const u32x4*)(kp0 + (size_t)(kt) * ks0); if (tid < 256) kB = *(const u32x4*)(kp1 + (size_t)(kt) * ks1); } while (0)
#define AT_LOADV(kt) do { vR = *(const u32x4*)(vp0 + (kt) * 64); } while (0)
#define AT_STOREK(bi) do { bf16_t* Kw_ = (bf16_t*)(lds + (bi) * AT_KB); *(u32x4*)(Kw_ + key0 * AK + part0 * 8) = kA; if (tid < 256) *(u32x4*)(Kw_ + key1 * AK + part1 * 8) = kB; } while (0)
#define AT_STOREV(bi) do { bf16_t* Vw_ = (bf16_t*)(lds + 2 * AT_KB + (bi) * AT_VB); *(u32x4*)(Vw_ + ve * AV + vpart * 8) = vR; } while (0)
#define AT_QK(P0, P1, bi, CI) do { const bf16_t* Kt_ = (const bf16_t*)(lds + (bi) * AT_KB); P0 = CI; P1 = CI; \
        _Pragma("unroll") for (int s = 0; s < 6; ++s) { const bf16x8 a0_ = *(const bf16x8*)(Kt_ + r32 * AK + 16 * s + 8 * hi), a1_ = *(const bf16x8*)(Kt_ + (32 + r32) * AK + 16 * s + 8 * hi); \
            P0 = MFMA32(a0_, qr[s], P0); P1 = MFMA32(a1_, qr[s], P1); } } while (0)
    float mref, l_part = 0.f;
    f32x16 o0, o1, negm, sa0, sa1, sb0, sb1;
#pragma unroll
    for (int i = 0; i < 16; ++i) { o0[i] = 0.f; o1[i] = 0.f; negm[i] = 0.f; }
    AT_LOADK(0); AT_LOADV(0); AT_STOREK(0); AT_STOREV(0); AT_LOADK(1);
    __syncthreads();
    AT_QK(sa0, sa1, 0, negm);
    { float mx = fmaxf(sa0[0], sa1[0]);
#pragma unroll
      for (int i = 1; i < 16; ++i) mx = fmaxf(mx, fmaxf(sa0[i], sa1[i]));
      mx = fmaxf(mx, __shfl_xor(mx, 32));
      mref = mx;
#pragma unroll
      for (int i = 0; i < 16; ++i) { sa0[i] -= mx; sa1[i] -= mx; negm[i] = -mx; } }
    AT_STOREK(1); AT_LOADK(2); AT_LOADV(1);
    __syncthreads();
#define AT_STEP(C0, C1, N0, N1, kt) do { \
        if ((kt) + 2 < S / 64) AT_STOREK((kt) & 1); \
        if ((kt) + 1 < S / 64) AT_STOREV(((kt) + 1) & 1); \
        if ((kt) + 3 < S / 64) AT_LOADK((kt) + 3); \
        if ((kt) + 2 < S / 64) AT_LOADV((kt) + 2); \
        float mx_ = max3_asm(C0[0], C0[1], C1[0]); float my_ = max3_asm(C0[2], C0[3], C1[1]); mx_ = max3_asm(mx_, C1[2], C1[3]); \
        _Pragma("unroll") for (int i = 4; i < 16; i += 4) { mx_ = max3_asm(mx_, C0[i], C0[i + 1]); my_ = max3_asm(my_, C0[i + 2], C0[i + 3]); mx_ = max3_asm(mx_, C1[i], C1[i + 1]); my_ = max3_asm(my_, C1[i + 2], C1[i + 3]); } \
        mx_ = halves_max(max2_asm(mx_, my_)); \
        if (__builtin_expect(__any(mx_ > ATT_THR), 0)) { \
            const float dl_ = fmaxf(mx_, 0.f); mref += dl_; const float f_ = __builtin_amdgcn_exp2f(-dl_); l_part *= f_; \
            _Pragma("unroll") for (int i = 0; i < 16; ++i) { C0[i] -= dl_; C1[i] -= dl_; negm[i] = -mref; } \
            if (hi == 0) wsf[r32] = f_; \
            LDSWAIT(); \
            _Pragma("unroll") for (int r = 0; r < 16; ++r) { const float fr_ = wsf[crow(r, hi)]; o0[r] *= fr_; o1[r] *= fr_; } \
        } \
        if ((kt) + 1 < S / 64) AT_QK(N0, N1, ((kt) + 1) & 1, negm);     \
        float rs0_ = 0.f, rs1_ = 0.f, rs2_ = 0.f, rs3_ = 0.f; \
        _Pragma("unroll") for (int i = 0; i < 16; i += 4) { \
            C0[i] = __builtin_amdgcn_exp2f(C0[i]); C1[i] = __builtin_amdgcn_exp2f(C1[i]); rs0_ += C0[i] + C1[i]; \
            C0[i + 1] = __builtin_amdgcn_exp2f(C0[i + 1]); C1[i + 1] = __builtin_amdgcn_exp2f(C1[i + 1]); rs1_ += C0[i + 1] + C1[i + 1]; \
            C0[i + 2] = __builtin_amdgcn_exp2f(C0[i + 2]); C1[i + 2] = __builtin_amdgcn_exp2f(C1[i + 2]); rs2_ += C0[i + 2] + C1[i + 2]; \
            C0[i + 3] = __builtin_amdgcn_exp2f(C0[i + 3]); C1[i + 3] = __builtin_amdgcn_exp2f(C1[i + 3]); rs3_ += C0[i + 3] + C1[i + 3]; } \
        l_part += (rs0_ + rs1_) + (rs2_ + rs3_); \
        { const bf16_t* Vt_ = (const bf16_t*)(lds + 2 * AT_KB + ((kt) & 1) * AT_VB); \
          _Pragma("unroll") for (int kb = 0; kb < 2; ++kb) _Pragma("unroll") for (int hf = 0; hf < 2; ++hf) { \
            u32x4 w_; \
            if (kb == 0) { w_.x = pk2(C0[8 * hf + 0], C0[8 * hf + 1]); w_.y = pk2(C0[8 * hf + 2], C0[8 * hf + 3]); w_.z = pk2(C0[8 * hf + 4], C0[8 * hf + 5]); w_.w = pk2(C0[8 * hf + 6], C0[8 * hf + 7]); } \
            else { w_.x = pk2(C1[8 * hf + 0], C1[8 * hf + 1]); w_.y = pk2(C1[8 * hf + 2], C1[8 * hf + 3]); w_.z = pk2(C1[8 * hf + 4], C1[8 * hf + 5]); w_.w = pk2(C1[8 * hf + 6], C1[8 * hf + 7]); } \
            const bf16x8 A_ = __builtin_bit_cast(bf16x8, w_); \
            const int kofs_ = 32 * kb + 16 * hf + 8 * hi; \
            const bf16x8 B0_ = *(const bf16x8*)(Vt_ + r32 * AV + kofs_), B1_ = *(const bf16x8*)(Vt_ + (32 + r32) * AV + kofs_); \
            o0 = MFMA32(A_, B0_, o0); o1 = MFMA32(A_, B1_, o1); } } \
          \
        _Pragma("unroll") for (int g_ = 0; g_ < 12; ++g_) { __builtin_amdgcn_sched_group_barrier(0x008, 1, 0); __builtin_amdgcn_sched_group_barrier(0x100, 2, 0); __builtin_amdgcn_sched_group_barrier(0x002, 5, 0); } \
        _Pragma("unroll") for (int g_ = 0; g_ < 8; ++g_) { __builtin_amdgcn_sched_group_barrier(0x008, 1, 0); __builtin_amdgcn_sched_group_barrier(0x100, 1, 0); __builtin_amdgcn_sched_group_barrier(0x002, 4, 0); } \
        __syncthreads(); \
    } while (0)
    for (int kt = 0; kt < S / 64; kt += 2) {
        AT_STEP(sa0, sa1, sb0, sb1, kt);
        AT_STEP(sb0, sb1, sa0, sa1, kt + 1);
    }
    float l_run = l_part + __shfl_xor(l_part, 32);
    if (hi == 0) wsf[32 + r32] = l_run;
    LDSWAIT();
    int q0l = q0; LAUNDER_V(q0l);
#pragma unroll
    for (int r = 0; r < 16; ++r) {
        const float rl = 1.0f / wsf[32 + crow(r, hi)];
        bf16_t* orow = MIX + (row0 + q0l + crow(r, hi)) * 1024 + 256 + h * 64;
        orow[r32] = (bf16_t)(pk2(o0[r] * rl, 0.f) & 0xffffu); orow[32 + r32] = (bf16_t)(pk2(o1[r] * rl, 0.f) & 0xffffu);
    }
    LDSWAIT();
    __syncthreads();
#undef AT_LOADK
#undef AT_LOADV
#undef AT_STOREK
#undef AT_STOREV
#undef AT_QK
#undef AT_STEP
}

constexpr int RK = 72;
__device__ __forceinline__ void ret_out(const Params& P, int l, unsigned char* lds, int u, int tid) {
    const int lane = tid & 63, r32 = lane & 31, hi = lane >> 5, wid = tid >> 6;
    bf16_t* Kl = (bf16_t*)lds;
    bf16_t* Vt = Kl + 2 * 128 * RK;
    const bf16_t* ZR = (const bf16_t*)(kws() + WS_ZR); const bf16_t* RT = (const bf16_t*)(kws() + WS_RT); bf16_t* MIX = (bf16_t*)(kws() + WS_H);
    const float* lr = (const float*)kin(26) + l * 8; const float* gn = (const float*)kin(27) + l * 256;
    const int b = u >> 6, h = (u >> 4) & 3, np = u & 15;
    const float lgf2 = -expf(lr[h]) * LOG2E, lgb2 = -expf(lr[4 + h]) * LOG2E;
    const size_t t0 = (size_t)b * S + np * 256;
#pragma unroll
    for (int it = 0; it < 4; ++it) {
        const int idx = tid + 512 * it;
        { const int part = idx & 7, key = (idx >> 3) & 127, ck = idx >> 10;
          const u32x4 kv = *(const u32x4*)(ZR + (t0 + ck * 128 + key) * 1024 + 256 + h * 64 + part * 8);
          *(u32x4*)(Kl + (ck * 128 + key) * RK + part * 8) = kv; }
        { const int key = idx & 127, e8 = ((idx >> 7) & 7) * 8, ck = idx >> 10;
          const u32x4 v = *(const u32x4*)(ZR + (t0 + ck * 128 + key) * 1024 + 512 + h * 64 + e8);
#pragma unroll
          for (int i = 0; i < 8; ++i) Vt[(ck * 64 + e8 + i) * RS + key] = (bf16_t)((v[i >> 1] >> (16 * (i & 1))) & 0xffffu); }
    }
    __syncthreads();
    const int ck = wid >> 2, c0 = 32 * (wid & 3);
    const size_t tc = t0 + ck * 128;
    const int n = np * 2 + ck;
    bf16x8 qr[4];
#pragma unroll
    for (int s = 0; s < 4; ++s) qr[s] = *(const bf16x8*)(ZR + (tc + c0 + r32) * 1024 + h * 64 + 16 * s + 8 * hi);
    const bf16_t* Kc = Kl + ck * 128 * RK; const bf16_t* Vc = Vt + ck * 64 * RS;
    f32x16 o0, o1;
#pragma unroll
    for (int i = 0; i < 16; ++i) { o0[i] = 0.f; o1[i] = 0.f; }
    const int cq = c0 + r32;
#pragma unroll 1
    for (int kb = 0; kb < 4; ++kb) {
        f32x16 p;
#pragma unroll
        for (int i = 0; i < 16; ++i) p[i] = 0.f;
#pragma unroll
        for (int s = 0; s < 4; ++s) { const bf16x8 a = *(const bf16x8*)(Kc + (32 * kb + r32) * RK + 16 * s + 8 * hi); p = MFMA32(a, qr[s], p); }
#pragma unroll
        for (int r = 0; r < 16; ++r) { const int mkey = 32 * kb + crow(r, hi); const int df = cq - mkey;
            const float wgt = df >= 0 ? __builtin_amdgcn_exp2f(lgf2 * (float)df) : __builtin_amdgcn_exp2f(lgb2 * (float)(-df)); p[r] *= wgt; }
#pragma unroll
        for (int hf = 0; hf < 2; ++hf) {
            u32x4 w; w.x = pk2(p[8 * hf + 0], p[8 * hf + 1]); w.y = pk2(p[8 * hf + 2], p[8 * hf + 3]); w.z = pk2(p[8 * hf + 4], p[8 * hf + 5]); w.w = pk2(p[8 * hf + 6], p[8 * hf + 7]);
            const bf16x8 A = __builtin_bit_cast(bf16x8, w);
            const int kofs = 32 * kb + 16 * hf + 4 * hi;
            const s16x4 l0 = *(const s16x4*)(Vc + r32 * RS + kofs), h0 = *(const s16x4*)(Vc + r32 * RS + kofs + 8);
            const s16x4 l1 = *(const s16x4*)(Vc + (32 + r32) * RS + kofs), h1 = *(const s16x4*)(Vc + (32 + r32) * RS + kofs + 8);
            const bf16x8 B0 = __builtin_shufflevector(l0, h0, 0, 1, 2, 3, 4, 5, 6, 7), B1 = __builtin_shufflevector(l1, h1, 0, 1, 2, 3, 4, 5, 6, 7);
            o0 = MFMA32(A, B0, o0); o1 = MFMA32(A, B1, o1);
        }
    }
    const int unit = (b * 4 + h) * 32 + n;
#pragma unroll 1
    for (int dir = 0; dir < 2; ++dir) {
        const bf16_t* Rt = RT + ((size_t)unit * 2 + dir) * 4096;
        const float wq = dir == 0 ? __builtin_amdgcn_exp2f(lgf2 * (float)(cq + 1)) : __builtin_amdgcn_exp2f(lgb2 * (float)(128 - cq));
#pragma unroll
        for (int s = 0; s < 4; ++s) {
            u32x4 w;
#pragma unroll
            for (int j = 0; j < 4; ++j) w[j] = pk2(bf2f((unsigned short)qr[s][2 * j]) * wq, bf2f((unsigned short)qr[s][2 * j + 1]) * wq);
            const bf16x8 A = __builtin_bit_cast(bf16x8, w);
            const bf16x8 b0 = *(const bf16x8*)(Rt + r32 * 64 + 16 * s + 8 * hi), b1 = *(const bf16x8*)(Rt + (32 + r32) * 64 + 16 * s + 8 * hi);
            o0 = MFMA32(A, b0, o0); o1 = MFMA32(A, b1, o1);
        }
    }
    const float g0 = gn[h * 64 + r32], g1 = gn[h * 64 + 32 + r32];
    int c0f = c0; LAUNDER_V(c0f);
#pragma unroll
    for (int r = 0; r < 16; ++r) {
        const float mean = half_sum(o0[r] + o1[r]) * (1.0f / 64.0f);
        const float d0 = o0[r] - mean, d1 = o1[r] - mean;
        const float var = half_sum(d0 * d0 + d1 * d1) * (1.0f / 64.0f);
        const float rstd = 1.0f / sqrtf(var + 1e-5f);
        const size_t t = tc + c0f + crow(r, hi);
        const float ga = bf2f(ZR[t * 1024 + 768 + h * 64 + r32]), gb = bf2f(ZR[t * 1024 + 768 + h * 64 + 32 + r32]);
        const float sa = ga / (1.0f + __expf(-ga)), sb = gb / (1.0f + __expf(-gb));
        MIX[t * 1024 + 768 + h * 64 + r32] = (bf16_t)(pk2(sa * d0 * rstd * g0, 0.f) & 0xffffu);
        MIX[t * 1024 + 768 + h * 64 + 32 + r32] = (bf16_t)(pk2(sb * d1 * rstd * g1, 0.f) & 0xffffu);
    }
    __syncthreads();
}

#define LAS __attribute__((address_space(3)))
#define XB_TMO      128
#define XB_XCNT(j)  (256  + 64 * (j))
#define XB_XSUB(j)  (1280 + 64 * (j))
#define XB_XGEN(j)  (2304 + 64 * (j))
#define XB_TOP      3328
#define XB_TOPGEN   3392
#define XCD_BAR_WORDS 3456
#define XB_SPIN_CAP (1u << 18)

__device__ __forceinline__ unsigned xb_ld(unsigned* p)              { return __hip_atomic_load(p, __ATOMIC_RELAXED, __HIP_MEMORY_SCOPE_AGENT); }
__device__ __forceinline__ unsigned xb_add(unsigned* p, unsigned v) { return __hip_atomic_fetch_add(p, v, __ATOMIC_RELAXED, __HIP_MEMORY_SCOPE_AGENT); }
__device__ __forceinline__ unsigned xb_xcc_id() { return (unsigned)__builtin_amdgcn_s_getreg((3 << 11) | 20) & 0xFu; }
#define XB_SPIN(cond, bar) do { unsigned _sp = 0; while (cond) { __builtin_amdgcn_s_sleep(1); \
    if ((++_sp & 255u) == 0u) { if (xb_ld(&(bar)[XB_TMO])) break; if (_sp > XB_SPIN_CAP) { atomicAdd(&(bar)[XB_TMO], 1u); break; } } } } while (0)

struct XcdBarrier {
    unsigned* bar; unsigned x; int tid;
    volatile LAS unsigned* st;
};

__device__ __forceinline__ XcdBarrier xcd_barrier_post(unsigned* bar, volatile LAS unsigned* st) {
    XcdBarrier b; b.bar = bar; b.x = xb_xcc_id(); b.st = st;
    if (threadIdx.x == 0) (void)xb_add(&bar[XB_XCNT(b.x)], 1u);
    return b;
}
__device__ __forceinline__ void xcd_barrier_complete(unsigned* bar, unsigned x, unsigned& nloc, unsigned& nx) {
    const unsigned G = gridDim.x * gridDim.y * gridDim.z;
    unsigned sum, cnt, mine, sp = 0u;
    for (;;) {
        sum = 0u; cnt = 0u; mine = 0u;
#pragma unroll
        for (unsigned j = 0; j < 16; ++j) { const unsigned c = xb_ld(&bar[XB_XCNT(j)]); sum += c; cnt += (c > 0u) ? 1u : 0u; mine = (j == x) ? c : mine; }
        if (sum == G) break;
        __builtin_amdgcn_s_sleep(1);
        if ((++sp & 255u) == 0u) { if (xb_ld(&bar[XB_TMO])) break; if (sp > XB_SPIN_CAP) { atomicAdd(&bar[XB_TMO], 1u); break; } }
    }
    nloc = mine > 0u ? mine : 1u; nx = cnt > 0u ? cnt : 1u;
}

__device__ __forceinline__ void xcd_barrier(const XcdBarrier& b) {
    asm volatile("s_waitcnt vmcnt(0)" ::: "memory");
    __syncthreads();
    if (b.tid == 0) {
        unsigned* bar = b.bar;
        __builtin_amdgcn_s_waitcnt(0);
        unsigned nloc = b.st[0], nx = b.st[1];
        if (nloc == 0u) { xcd_barrier_complete(bar, b.x, nloc, nx); b.st[0] = nloc; b.st[1] = nx; }
        const unsigned old = xb_add(&bar[XB_XSUB(b.x)], 1u);
        const unsigned gen = old / nloc;
        if (old + 1u == (gen + 1u) * nloc) {
            __builtin_amdgcn_fence(__ATOMIC_RELEASE, "agent");
            asm volatile("s_waitcnt vmcnt(0)" ::: "memory");
            const unsigned og = xb_add(&bar[XB_TOP], 1u);
            const unsigned tg = og / nx;
            if (og + 1u == (tg + 1u) * nx) xb_add(&bar[XB_TOPGEN], 1u);
            else XB_SPIN(xb_ld(&bar[XB_TOPGEN]) == tg, bar);
            __builtin_amdgcn_fence(__ATOMIC_ACQUIRE, "agent");
            xb_add(&bar[XB_XGEN(b.x)], 1u);
            asm volatile("s_waitcnt vmcnt(0)" ::: "memory");
        } else {
            XB_SPIN(xb_ld(&bar[XB_XGEN(b.x)]) == gen, bar);
            __builtin_amdgcn_fence(__ATOMIC_ACQUIRE, "agent");
            asm volatile("s_waitcnt vmcnt(0)" ::: "memory");
        }
    }
    __syncthreads();
}

constexpr size_t WS_BAR = 819200;
__global__ void __launch_bounds__(512, 2) fwd_megakernel(Params Pdummy) {
    extern __shared__ __attribute__((aligned(16))) unsigned char lds[];
    cg::grid_group grid = cg::this_grid();
    const int G = gridDim.x, bid = blockIdx.x;
    const int wave_s = __builtin_amdgcn_readfirstlane((int)threadIdx.x >> 6);
#define HWTID() (wave_s * 64 + (int)__builtin_amdgcn_mbcnt_hi(~0u, __builtin_amdgcn_mbcnt_lo(~0u, 0u)))
    const Params& P = Pdummy;
    PG8_LAS unsigned char* ldsl = (PG8_LAS unsigned char*)lds;
    unsigned* barw = (unsigned*)(kws() + WS_BAR);
    volatile LAS unsigned* MISCp = (volatile LAS unsigned*)(ldsl + 131072 + 512);
    { int tid = threadIdx.x; LAUNDER_V(tid);
      if (bid == 0) for (int i = tid; i < XCD_BAR_WORDS; i += 512) __hip_atomic_store(barw + i, 0u, __ATOMIC_RELAXED, __HIP_MEMORY_SCOPE_AGENT);
      if (bid == 0 && tid < 64) __hip_atomic_store((unsigned*)(kws() + WS_CTR) + tid * 64, 0u, __ATOMIC_RELAXED, __HIP_MEMORY_SCOPE_AGENT);
      if (tid < 2) MISCp[tid] = 0u;
      __threadfence();
      __syncthreads();
#ifndef SKIP_MOD
      phase_mod(P, lds, tid);
#endif
    }
    grid.sync();
    (void)xcd_barrier_post(barw, MISCp);
    for (int step = 0; step < L * 14; ++step) {
        const int l = step / 14, k = step % 14;
        if (k == 7) continue;
#ifndef REPMASK
#define REPMASK 0
#endif
#ifndef SUBMASK
#define SUBMASK 0
#endif
        const int nrep = ((REPMASK >> k) & 1) ? 2 : 1;
        for (int rep = 0; rep < nrep; ++rep) {
        int tid = HWTID(); LAUNDER_V(tid);
        const int lane = tid & 63, wave = tid >> 6;
        const int vcu = (G % 8 == 0) ? (bid % 8) * (G / 8) + bid / 8 : bid;
        const int gw = vcu * 8 + wave, NGW = G * 8;
        unsigned char* ws = kws();
        const float* modl = (const float*)(ws + WS_MOD) + (size_t)l * 4 * 9216;
        pg8::Gemm g{nullptr, nullptr, 0, 0, 0}; pg8::EpiX E{0, nullptr, nullptr, nullptr, 0.f, 0}; bool do_gemm = false;
        switch (k) {
        case 0:
#ifndef SKIP_CONV
            convert_weights(P, l, lds, gw, NGW, wave, lane);
#endif
            norm_rows(P, l == 0 ? (const float*)kin(0) : kout(), l == 0 ? kout() : nullptr, l, 0, gw, NGW, lane);
            break;
        case 1:
            g = pg8::Gemm{(const bf16_t*)(ws + WS_H), (const bf16_t*)(ws + WS_WBF + WB_W1A), T, 5632, 1024}; E = pg8::EpiX{0, nullptr, (bf16_t*)(ws + WS_A), nullptr, 0.f, FF}; do_gemm = true; break;
        case 2:
            g = pg8::Gemm{(const bf16_t*)(ws + WS_A), (const bf16_t*)(ws + WS_WBF + WB_W2A), T, 1024, FF}; E = pg8::EpiX{1, kout(), nullptr, modl + 2 * 1024, 0.5f, 0}; do_gemm = true; break;
        case 3:
            norm_rows(P, kout(), nullptr, l, 3, gw, NGW, lane); break;
        case 4:
            g = pg8::Gemm{(const bf16_t*)(ws + WS_H), (const bf16_t*)(ws + WS_WBF + WB_WIN), T, 3072, 1024}; E = pg8::EpiX{2, (float*)(ws + WS_ZF), (bf16_t*)(ws + WS_ZR), nullptr, 0.f, 0}; do_gemm = true; break;
        case 5:
#ifndef SKIP_RPREP
            rwkv_prep(P, l, lds, tid);
#endif
#ifndef SKIP_MPREP
            mla_prep(P, l, gw, NGW, lane);
#endif
            __syncthreads();
#ifndef SKIP_RSTATE
            if (rep == 0) ret_state(P, l, lds, tid);
#endif
            break;
        case 6:
#ifndef SKIP_RSCAN
            ret_scan(P, l, tid);
#endif
            g = pg8::Gemm{(const bf16_t*)(ws + WS_CQN), (const bf16_t*)(ws + WS_WBF + WB_WUQ), T, 768, 384}; E = pg8::EpiX{3, nullptr, (bf16_t*)(ws + WS_QB), nullptr, 0.f, 768}; do_gemm = true; break;
        case 7:
            break;
        case 8:
#ifndef SKIP_SCAN
            for (int sr = 0; sr < ((SUBMASK & 1) ? 2 : 1); ++sr) {
            const int sbx = (((bid & 7) + 8 * ((bid >> 3) >> 2)) << 2) | ((bid >> 3) & 3);
            if (bid < 128) { if (bid >= 64) rwkv_scan_dir<1>(P, lds, sbx, tid); else rwkv_scan_dir<0>(P, lds, sbx, tid); }
            __syncthreads();
            }
#endif
            {
                unsigned* ctrl = (unsigned*)(kws() + WS_CTR) + l * 16 * 64;
                volatile unsigned* slot = (volatile unsigned*)(lds + 131072 + 1024);
                const int x0 = (int)(xb_xcc_id() & 7u);
                volatile unsigned* avail = slot + 4;
                for (;;) {
                    __syncthreads();
                    if (tid < 9) avail[tid] = __hip_atomic_load(ctrl + tid * 64, __ATOMIC_RELAXED, __HIP_MEMORY_SCOPE_AGENT);
                    __syncthreads();
                    int xs = 0;
                    for (; xs < 9; ++xs) { const int q_ = xs < 8 ? ((x0 + xs) & 7) : 8; if (avail[q_] < (xs < 8 ? 64u : 256u)) break; }
                    if (xs == 9) break;
                    const int qx = xs < 8 ? ((x0 + xs) & 7) : 8;
                    const unsigned qn = xs < 8 ? 64u : 256u;
                    for (;;) {
                        __syncthreads();
                        if (tid == 0) *slot = atomicAdd(ctrl + qx * 64, 1u);
                        __syncthreads();
                        const unsigned u = *slot;
                        if (u >= qn) break;
                        int tq = tid; LAUNDER_V(tq);
                        if (xs < 8) { const int bh = qx * 4 + (int)(u >> 4); attn_unit(P, lds, bh >> 3, bh & 7, (int)(u & 15), tq); }
                        else ret_out(P, l, lds, (int)u, tq);
                    }
                }
            }
            break;
        case 9:
#ifndef SKIP_RPOST
            rwkv_post(P, l, gw, NGW, lane);
#endif
            break;
        case 10:
            g = pg8::Gemm{(const bf16_t*)(ws + WS_H), (const bf16_t*)(ws + WS_WBF + WB_WOUT), T, 1024, 1024}; E = pg8::EpiX{1, kout(), nullptr, modl + 5 * 1024, 1.0f, 0}; do_gemm = true; break;
        case 11:
            norm_rows(P, kout(), nullptr, l, 6, gw, NGW, lane); break;
        case 12:
            g = pg8::Gemm{(const bf16_t*)(ws + WS_H), (const bf16_t*)(ws + WS_WBF + WB_W1B), T, 5632, 1024}; E = pg8::EpiX{0, nullptr, (bf16_t*)(ws + WS_A), nullptr, 0.f, FF}; do_gemm = true; break;
        default:
            g = pg8::Gemm{(const bf16_t*)(ws + WS_A), (const bf16_t*)(ws + WS_WBF + WB_W2B), T, 1024, FF}; E = pg8::EpiX{1, kout(), nullptr, modl + 8 * 1024, 0.5f, 0}; do_gemm = true; break;
        }
        if (rep > 0 && E.MODE == 1) E.coef = 0.f;
        if (do_gemm) {
            const int ngemm = (k == 6) ? 2 : 1;
            for (int gi = 0; gi < ngemm; ++gi) {
                int tg = tid; LAUNDER_V(tg);
                if (gi == 1) { g = pg8::Gemm{(const bf16_t*)(ws + WS_CKVN), (const bf16_t*)(ws + WS_WBF + WB_WUKV), T, 1024, 256}; E = pg8::EpiX{4, (float*)(ws + WS_VT), (bf16_t*)(ws + WS_KVB), nullptr, 0.f, 1024}; }
                pg8::StaticOrder So; So.init(g.M, g.N, G, bid); pg8::gemm_phase<pg8::EpiX, pg8::StaticOrder, true, true>(ldsl, g, So, E, tg);
            }
        }
        { XcdBarrier xb; xb.bar = (unsigned*)(kws() + WS_BAR); xb.x = xb_xcc_id(); xb.tid = tid; xb.st = (volatile LAS unsigned*)(ldsl + 131072 + 512); xcd_barrier(xb); }
        }
    }
    { int tid = HWTID(); LAUNDER_V(tid);
      const int lane = tid & 63, wave = tid >> 6;
      const int vcu = (G % 8 == 0) ? (bid % 8) * (G / 8) + bid / 8 : bid;
      final_norm(P, vcu * 8 + wave, G * 8, lane); }
}
}

extern "C" void kernel_launch(void* const* d_in, const int* in_sizes, int n_in, void* d_out, int out_size, void* d_ws, size_t ws_size, hipStream_t stream) {
    static int grid = 0;
    if (grid == 0) {
        if (n_in != 29 || out_size != mk::T * mk::D || ws_size < mk::WS_END) { fprintf(stderr, "kernel_launch: unexpected shapes (n_in %d, out %d, ws %zu)\n", n_in, out_size, ws_size); grid = -1; return; }
        int dev = 0, cus = 0, per_cu = 0;
        hipGetDevice(&dev);
        hipDeviceGetAttribute(&cus, hipDeviceAttributeMultiprocessorCount, dev);
        hipFuncSetAttribute((const void*)mk::fwd_megakernel, hipFuncAttributeMaxDynamicSharedMemorySize, mk::LDS_BYTES);
        hipOccupancyMaxActiveBlocksPerMultiprocessor(&per_cu, (const void*)mk::fwd_megakernel, 512, mk::LDS_BYTES);
        if (per_cu < 1) per_cu = 1;
        grid = cus * per_cu;
        (void)hipGetLastError();
    }
    if (grid < 0) return;
    mk::Params p{};
    for (int i = 0; i < 29; ++i) p.in[i] = d_in[i];
    p.out = (float*)d_out; p.ws = (unsigned char*)d_ws;
    void* args[] = {&p};
    hipError_t e = hipLaunchCooperativeKernel((const void*)mk::fwd_megakernel, dim3(grid), dim3(512), args, mk::LDS_BYTES, stream);
    if (e != hipSuccess) fprintf(stderr, "cooperative launch failed: %s (grid %d)\n", hipGetErrorString(e), grid);
}
```

```cpp
#include <hip/hip_runtime.h>
#include <hip/hip_cooperative_groups.h>
#include <cstdio>
#include <cstdint>
#include <cmath>
namespace cg = cooperative_groups;
namespace pg8 {
#define PG8_LAS __attribute__((address_space(3)))
typedef unsigned short bf16_t;
typedef short bf16x8 __attribute__((ext_vector_type(8)));
typedef float f32x4 __attribute__((ext_vector_type(4)));
typedef unsigned u32x4 __attribute__((ext_vector_type(4)));
constexpr int BM = 256, BK = 64, HALF = 128, HTB = HALF * BK * 2  , STAGE_BYTES = 8 * HTB, NXCD = 8, WGM = 8;

__host__ __device__ __forceinline__ int lds_byte(int r, int c) { const int st = (r >> 4) * 2 + (c >> 5), rr = r & 15, cc = c & 31, ob = rr * 64 + cc * 2; return st * 1024 + (ob ^ (((ob >> 9) & 1) << 5)); }
__host__ __device__ __forceinline__ void stage_rc(int b, int& R, int& C) { const int st = b / 1024, sb = b % 1024, swz = sb ^ (((sb >> 9) & 1) << 5); R = (st >> 1) * 16 + swz / 64; C = (st & 1) * 32 + (swz % 64) / 2; }
__host__ __device__ __forceinline__ int perm32(int rho) { const int n = rho >> 4, i = rho & 15; return 8 * (i >> 2) + 4 * n + (i & 3); }

struct Unit { int pm, pn; };
struct Gemm { const bf16_t* A; const bf16_t* Bt; int M, N, K; };

struct StaticOrder {
    int nM, nN, nwg, G, c;
    __host__ __device__ void init(int M, int N, int G_, int c_) { nM = M / BM; nN = N / BM; nwg = nM * nN; G = G_; c = c_; }
    __host__ __device__ bool next(int i, Unit& u) const {
        const long L = (long)i * G + c; if (L >= nwg) return false;
        int wgid = (int)L; { const int q = nwg / NXCD, r = nwg % NXCD, xcd = wgid % NXCD, off = wgid / NXCD; wgid = (xcd < r ? xcd * (q + 1) : r * (q + 1) + (xcd - r) * q) + off; }
        const int nig = WGM * nN, gid = wgid / nig, fm = gid * WGM, gsz = (nM - fm) < WGM ? (nM - fm) : WGM;
        u.pm = fm + ((wgid % nig) % gsz); u.pn = (wgid % nig) / gsz; return true;
    }
    __device__ __forceinline__ void a_ready(const Unit&) const {}
    __device__ __forceinline__ void done(const Unit&) const {}
};

__device__ __forceinline__ unsigned cvt_pk_bf16(float lo, float hi) { unsigned r; asm volatile("v_cvt_pk_bf16_f32 %0, %1, %2" : "=v"(r) : "v"(lo), "v"(hi)); return r; }
typedef float f32x2 __attribute__((ext_vector_type(2)));
typedef unsigned u32x2e __attribute__((ext_vector_type(2)));
typedef __bf16 bf16x2e __attribute__((ext_vector_type(2)));
__device__ __forceinline__ unsigned pk_bf16_rne(float lo, float hi) { f32x2 v = {lo, hi}; bf16x2e b = __builtin_convertvector(v, bf16x2e); return __builtin_bit_cast(unsigned, b); }
__device__ __forceinline__ float silu_f(float x) { return x * __builtin_amdgcn_rcpf(1.0f + __expf(-x)); }
struct EpiX {
    int MODE;
    static constexpr bool PERM = false, AFTER_DRAIN = false;
    float* F; bf16_t* Hh; const float* gv; float coef; int ldo;
    __device__ __forceinline__ void operator()(const f32x4 (&acc)[2][2][4][2], const Unit& u, int wr, int wc, int fr, int fq) const {
#pragma unroll
        for (int ai = 0; ai < 2; ++ai)
#pragma unroll
            for (int m = 0; m < 4; ++m) {
                const int r = u.pm * BM + ai * HALF + wr * 64 + m * 16 + fr;
#pragma unroll
                for (int bj = 0; bj < 2; ++bj) {
                    const int cb = u.pn * BM + bj * HALF + wc * 32;
                    const f32x4 v0 = acc[ai][bj][m][0], v1 = acc[ai][bj][m][1];
                    if (MODE == 0) {
                        u32x2e w; w.x = pk_bf16_rne(silu_f(v0[0]) * v1[0], silu_f(v0[1]) * v1[1]); w.y = pk_bf16_rne(silu_f(v0[2]) * v1[2], silu_f(v0[3]) * v1[3]);
                        *(u32x2e*)(Hh + (size_t)r * ldo + (cb >> 1) + 4 * fq) = w;
                    } else if (MODE == 1) {
                        const int b = r >> 12;
#pragma unroll
                        for (int n = 0; n < 2; ++n) { const int c = cb + 16 * n + 4 * fq; const f32x4 g = *(const f32x4*)(gv + b * 9216 + c); f32x4* xp = (f32x4*)(F + (size_t)r * 1024 + c);
                            f32x4 x = *xp; x += (n == 0 ? v0 : v1) * g * coef; *xp = x; }
                    } else if (MODE == 2) {
                        if (u.pn < 8) {
                            *(f32x4*)(F + (size_t)r * 2048 + cb + 4 * fq) = v0; *(f32x4*)(F + (size_t)r * 2048 + cb + 16 + 4 * fq) = v1;
                        } else {
                            u32x2e w0, w1; w0.x = pk_bf16_rne(v0[0], v0[1]); w0.y = pk_bf16_rne(v0[2], v0[3]); w1.x = pk_bf16_rne(v1[0], v1[1]); w1.y = pk_bf16_rne(v1[2], v1[3]);
                            *(u32x2e*)(Hh + (size_t)r * 1024 + (cb - 2048) + 4 * fq) = w0; *(u32x2e*)(Hh + (size_t)r * 1024 + (cb - 2048) + 16 + 4 * fq) = w1;
                        }
                    } else if (MODE == 4 && wc >= 2) {
                        const int hh = u.pn * 2 + bj, e0 = (wc - 2) * 32 + 4 * fq, bb = r >> 12, ss = r & 4095;
                        const int ssp = (ss & ~12) | ((ss & 4) << 1) | ((ss & 8) >> 1);
                        bf16_t* vt = (bf16_t*)F + ((size_t)((bb * 8 + hh) * 64 + e0)) * 4096 + ssp;
#pragma unroll
                        for (int j = 0; j < 4; ++j) { vt[(size_t)j * 4096] = (bf16_t)(pk_bf16_rne(v0[j], 0.f) & 0xffffu); vt[(size_t)(16 + j) * 4096] = (bf16_t)(pk_bf16_rne(v1[j], 0.f) & 0xffffu); }
                    } else {
                        u32x2e w0, w1; w0.x = pk_bf16_rne(v0[0], v0[1]); w0.y = pk_bf16_rne(v0[2], v0[3]); w1.x = pk_bf16_rne(v1[0], v1[1]); w1.y = pk_bf16_rne(v1[2], v1[3]);
                        *(u32x2e*)(Hh + (size_t)r * ldo + cb + 4 * fq) = w0; *(u32x2e*)(Hh + (size_t)r * ldo + cb + 16 + 4 * fq) = w1;
                    }
                }
            }
    }
};
template <class Epi, class Sched, bool ALIGN_EPI = false, bool SP2 = false>
__device__ __forceinline__ void gemm_phase(PG8_LAS unsigned char* lds, const Gemm g, const Sched& S, const Epi& E, int tid_in) {
    int tid_l = tid_in; asm volatile("" : "+v"(tid_l));
    const int tid = tid_l, wid = __builtin_amdgcn_readfirstlane(tid >> 6), lane = tid & 63, wr = wid >> 2, wc = wid & 3, fr = lane & 15, fq = lane >> 4;
    const int K = g.K, nt = K / BK;
    unsigned voffA[2], voffB[2];
#pragma unroll
    for (int i = 0; i < 2; ++i) { int R, C; stage_rc(tid * 16 + i * 8192, R, C); const int Rb = Epi::PERM ? ((R & ~31) + perm32(R & 31)) : R;
        voffA[i] = (unsigned)(R * K + C) * 2u; voffB[i] = (unsigned)(Rb * K + C) * 2u; }
    const size_t kstep = (size_t)(BK * 2);
    const size_t hstep = (size_t)HALF * K * 2;
    const size_t tstep = 2 * hstep;
    const unsigned ldsw = (unsigned)wid * 1024u;
    const int aoff = lds_byte(wr * 64 + fr, fq * 8), boff = lds_byte(wc * 32 + fr, fq * 8);
#define PG8_SA(b, h) (((b) * 2 + (h)) * HTB)
#define PG8_SB(b, h) ((4 + (b) * 2 + (h)) * HTB)
#define PG8_STAGE(bufoff, gbase, voff) do { _Pragma("unroll") for (int _i = 0; _i < 2; ++_i) \
        __builtin_amdgcn_global_load_lds((const unsigned*)((const char*)(gbase) + (voff)[_i]), (PG8_LAS unsigned*)(lds + (bufoff) + ldsw + _i * 8192), 16, 0, 0); } while (0)
#define PG8_LDA(dst, b, h) do { _Pragma("unroll") for (int m = 0; m < 4; ++m) _Pragma("unroll") for (int k = 0; k < 2; ++k) dst[m][k] = *(const PG8_LAS bf16x8*)(lds + PG8_SA(b, h) + aoff + m * 2048 + k * 1024); } while (0)
#define PG8_LDB(dst, b, h) do { _Pragma("unroll") for (int n = 0; n < 2; ++n) _Pragma("unroll") for (int k = 0; k < 2; ++k) dst[n][k] = *(const PG8_LAS bf16x8*)(lds + PG8_SB(b, h) + boff + n * 2048 + k * 1024); } while (0)
#define PG8_MMA(ai, bj, At, Bt) do { __builtin_amdgcn_s_setprio(1); _Pragma("unroll") for (int m = 0; m < 4; ++m) _Pragma("unroll") for (int n = 0; n < 2; ++n) _Pragma("unroll") for (int k = 0; k < 2; ++k) \
        acc[ai][bj][m][n] = __builtin_amdgcn_mfma_f32_16x16x32_bf16(Bt[n][k], At[m][k], acc[ai][bj][m][n], 0, 0, 0); __builtin_amdgcn_s_setprio(0); } while (0)
#define PG8_WAIT_V(n) asm volatile("s_waitcnt vmcnt(" #n ")" ::: "memory")
#define PG8_WAIT_L(n) asm volatile("s_waitcnt lgkmcnt(" #n ")" ::: "memory")
#define PG8_BAR __builtin_amdgcn_s_barrier()
#define PG8_SCHED __builtin_amdgcn_sched_barrier(0)
    Unit cur, nxt; int ui = 0;
    if (!S.next(0, cur)) return;
    f32x4 acc[2][2][4][2];
#pragma unroll
    for (int a = 0; a < 2; ++a)
#pragma unroll
        for (int b = 0; b < 2; ++b)
#pragma unroll
            for (int m = 0; m < 4; ++m)
#pragma unroll
                for (int n = 0; n < 2; ++n) acc[a][b][m][n] = (f32x4){0.f, 0.f, 0.f, 0.f};
    bf16x8 At[4][2], B0[2][2], B1[2][2];
    const char* cA = (const char*)g.A + (size_t)cur.pm * tstep; const char* cB = (const char*)g.Bt + (size_t)cur.pn * tstep;
    S.a_ready(cur);
    if constexpr (SP2) {
        PG8_STAGE(PG8_SB(0, 0), cB, voffB); PG8_STAGE(PG8_SB(0, 1), cB + hstep, voffB); PG8_STAGE(PG8_SA(0, 0), cA, voffA); PG8_STAGE(PG8_SA(0, 1), cA + hstep, voffA);
        if (wr == 1) PG8_BAR;
        PG8_WAIT_V(2); PG8_BAR;
        PG8_STAGE(PG8_SB(1, 0), cB + kstep, voffB); PG8_STAGE(PG8_SA(1, 0), cA + kstep, voffA); PG8_STAGE(PG8_SB(1, 1), cB + hstep + kstep, voffB);
        PG8_WAIT_V(6); PG8_BAR;
    } else {
        PG8_STAGE(PG8_SB(0, 0), cB, voffB); PG8_STAGE(PG8_SA(0, 0), cA, voffA); PG8_STAGE(PG8_SB(0, 1), cB + hstep, voffB); PG8_STAGE(PG8_SA(0, 1), cA + hstep, voffA);
        if (wr == 1) PG8_BAR;
        PG8_WAIT_V(4); PG8_BAR;
        PG8_STAGE(PG8_SB(1, 0), cB + kstep, voffB); PG8_STAGE(PG8_SA(1, 0), cA + kstep, voffA); PG8_STAGE(PG8_SB(1, 1), cB + hstep + kstep, voffB);
        PG8_WAIT_V(6); PG8_BAR;
    }
    for (;;) {
        const bool has_next = S.next(ui + 1, nxt);
        const char* nA = has_next ? (const char*)g.A + (size_t)nxt.pm * tstep : cA; const char* nB = has_next ? (const char*)g.Bt + (size_t)nxt.pn * tstep : cB;
        for (int t = 0; t < nt; t += 2) {
            const bool last = (t == nt - 2);
            const char* a1 = cA + (size_t)(t + 1) * kstep;
            const char* a2 = last ? nA : cA + (size_t)(t + 2) * kstep; const char* b2 = last ? nB : cB + (size_t)(t + 2) * kstep;
            const char* a3 = a2 + kstep; const char* b3 = b2 + kstep;
            if (last && has_next) S.a_ready(nxt);
            if constexpr (SP2) {
            PG8_LDB(B0, 0, 0); PG8_LDB(B1, 0, 1); PG8_SCHED; PG8_LDA(At, 0, 0); PG8_STAGE(PG8_SA(1, 1), a1 + hstep, voffA);
            PG8_WAIT_V(8); PG8_WAIT_L(0); PG8_BAR; PG8_MMA(0, 0, At, B0); PG8_MMA(0, 1, At, B1); PG8_BAR; PG8_SCHED;
            PG8_LDA(At, 0, 1); PG8_STAGE(PG8_SB(0, 0), b2, voffB); PG8_STAGE(PG8_SB(0, 1), b2 + hstep, voffB); PG8_STAGE(PG8_SA(0, 0), a2, voffA);
            PG8_WAIT_V(8); PG8_WAIT_L(0); PG8_BAR; PG8_MMA(1, 0, At, B0); PG8_MMA(1, 1, At, B1); PG8_BAR; PG8_SCHED;
            PG8_LDB(B0, 1, 0); PG8_LDB(B1, 1, 1); PG8_SCHED; PG8_LDA(At, 1, 0); PG8_STAGE(PG8_SA(0, 1), a2 + hstep, voffA);
            PG8_WAIT_V(8); PG8_WAIT_L(0); PG8_BAR; PG8_MMA(0, 0, At, B0); PG8_MMA(0, 1, At, B1); PG8_BAR; PG8_SCHED;
            PG8_LDA(At, 1, 1); PG8_STAGE(PG8_SB(1, 0), b3, voffB); PG8_STAGE(PG8_SB(1, 1), b3 + hstep, voffB); PG8_STAGE(PG8_SA(1, 0), a3, voffA);
            PG8_WAIT_V(8); PG8_WAIT_L(0); PG8_BAR; PG8_MMA(1, 0, At, B0); PG8_MMA(1, 1, At, B1); PG8_BAR; PG8_SCHED;
            } else {
            PG8_LDB(B0, 0, 0); PG8_SCHED; PG8_LDA(At, 0, 0); PG8_STAGE(PG8_SA(1, 1), a1 + hstep, voffA);
            PG8_WAIT_L(8); PG8_BAR; PG8_WAIT_L(0); PG8_MMA(0, 0, At, B0); PG8_BAR; PG8_SCHED;
            PG8_LDB(B1, 0, 1); PG8_STAGE(PG8_SB(0, 0), b2, voffB);
            PG8_BAR; PG8_WAIT_L(0); PG8_MMA(0, 1, At, B1); PG8_BAR;
            PG8_LDA(At, 0, 1); PG8_STAGE(PG8_SA(0, 0), a2, voffA);
            PG8_BAR; PG8_WAIT_L(0); PG8_MMA(1, 0, At, B0); PG8_BAR; PG8_SCHED;
            PG8_STAGE(PG8_SB(0, 1), b2 + hstep, voffB);
            PG8_WAIT_V(6); PG8_BAR; PG8_MMA(1, 1, At, B1); PG8_BAR;
            PG8_LDB(B0, 1, 0); PG8_SCHED; PG8_LDA(At, 1, 0); PG8_STAGE(PG8_SA(0, 1), a2 + hstep, voffA);
            PG8_WAIT_L(8); PG8_BAR; PG8_WAIT_L(0); PG8_MMA(0, 0, At, B0); PG8_BAR; PG8_SCHED;
            PG8_LDB(B1, 1, 1); PG8_STAGE(PG8_SB(1, 0), b3, voffB);
            PG8_BAR; PG8_WAIT_L(0); PG8_MMA(0, 1, At, B1); PG8_BAR;
            PG8_LDA(At, 1, 1); PG8_STAGE(PG8_SA(1, 0), a3, voffA);
            PG8_BAR; PG8_WAIT_L(0); PG8_MMA(1, 0, At, B0); PG8_BAR; PG8_SCHED;
            PG8_STAGE(PG8_SB(1, 1), b3 + hstep, voffB);
            PG8_WAIT_V(6); PG8_BAR; PG8_MMA(1, 1, At, B1); PG8_BAR;
            }
        }
        if constexpr (ALIGN_EPI) { if (wr == 0) PG8_BAR; }
        if constexpr (!Epi::AFTER_DRAIN) { E(acc, cur, wr, wc, fr, fq); S.done(cur); }
        if (!has_next) break;
#pragma unroll
        for (int a = 0; a < 2; ++a)
#pragma unroll
            for (int b = 0; b < 2; ++b)
#pragma unroll
                for (int m = 0; m < 4; ++m)
#pragma unroll
                    for (int n = 0; n < 2; ++n) acc[a][b][m][n] = (f32x4){0.f, 0.f, 0.f, 0.f};
        cur = nxt; cA = nA; cB = nB; ++ui;
        if constexpr (ALIGN_EPI) { if (wr == 1) PG8_BAR; }
    }
    PG8_WAIT_V(0);
    if constexpr (!ALIGN_EPI) { if (wr == 0) PG8_BAR; }
    PG8_BAR;
    if constexpr (Epi::AFTER_DRAIN) { E.fused(acc, cur, wr, wc, fr, fq, lds, wid, lane); S.done(cur); }
#undef PG8_SA
#undef PG8_SB
#undef PG8_STAGE
#undef PG8_LDA
#undef PG8_LDB
#undef PG8_MMA
#undef PG8_WAIT_V
#undef PG8_WAIT_L
#undef PG8_BAR
#undef PG8_SCHED
}
}
namespace mk {
using pg8::bf16_t; using pg8::bf16x8; using pg8::f32x4;
typedef float f32x16 __attribute__((ext_vector_type(16)));
typedef float f32x2 __attribute__((ext_vector_type(2)));
typedef unsigned u32x4 __attribute__((ext_vector_type(4)));
typedef unsigned u32x2 __attribute__((ext_vector_type(2)));
typedef short s16x4 __attribute__((ext_vector_type(4)));

constexpr int NB = 4, S = 4096, T = NB * S, D = 1024, L = 4, FF = 2816;
constexpr size_t MiB = 1u << 20;
constexpr size_t WS_MOD = 0, WS_WBF = 1 * MiB, WS_H = 44 * MiB, WS_ZF = 76 * MiB, WS_A = 76 * MiB, WS_Y = 76 * MiB, WS_QB = 108 * MiB, WS_KVB = 132 * MiB, WS_RT = 164 * MiB,
    WS_ZR = 204 * MiB, WS_CQN = 236 * MiB, WS_CKVN = 248 * MiB, WS_KPE = 256 * MiB, WS_DEC = 257 * MiB, WS_KKA = 289 * MiB, WS_KMOD = 321 * MiB, WS_KK = 353 * MiB,
    WS_RKV = 369 * MiB, WS_G = 417 * MiB, WS_KVT = 433 * MiB, WS_END = 449 * MiB, WS_VT = 172 * MiB, WS_CTR = 819200 + 16384;
constexpr size_t WB_W1A = 0, WB_W2A = 11534336, WB_W1B = 17301504, WB_W2B = 28835840, WB_WIN = 34603008, WB_WOUT = 40894464, WB_WUQ = 42991616, WB_WUKV = 43581440, WB_LWUP = 44105728, WB_LAUP = 44105728 + 65536, WB_LGUP = 44105728 + 131072;
constexpr int LDS_BYTES = 147456;
constexpr float LOG2E = 1.4426950408889634f, LOG2_1E4 = 13.287712379549449f;

struct Params { const void* in[29]; float* out; unsigned char* ws; };
typedef __attribute__((address_space(4))) const unsigned long long* karg_ptr;
__device__ __forceinline__ const void* kin(int i) { karg_ptr ka = (karg_ptr)__builtin_amdgcn_kernarg_segment_ptr(); asm volatile("" : "+s"(ka)); return (const void*)(__attribute__((address_space(1))) const void*)ka[i]; }
__device__ __forceinline__ float* kout() { return (float*)kin(29); }
__device__ __forceinline__ unsigned char* kws() { return (unsigned char*)kin(30); }
#define LAUNDER_V(x) asm volatile("" : "+v"(x))

__device__ __forceinline__ unsigned pk2(float lo, float hi) { return pg8::pk_bf16_rne(lo, hi); }
__device__ __forceinline__ float bf2f(unsigned short u) { return __uint_as_float(((unsigned)u) << 16); }
template <int CTRL> __device__ __forceinline__ float dppr_add(float x) { const int y = __builtin_amdgcn_update_dpp(0, __float_as_int(x), CTRL, 0xf, 0xf, false); return x + __int_as_float(y); }
__device__ __forceinline__ float row16_allsum(float x) { x = dppr_add<0x128>(x); x = dppr_add<0x124>(x); x = dppr_add<0x122>(x); x = dppr_add<0x121>(x); return x; }
__device__ __forceinline__ float wave_sum(float v) { v = row16_allsum(v); v += __shfl_xor(v, 16); v += __shfl_xor(v, 32); return v; }
__device__ __forceinline__ float half_sum(float v) { v = row16_allsum(v); v += __shfl_xor(v, 16); return v; }
__device__ __forceinline__ int crow(int r, int hi) { return (r & 3) + 8 * (r >> 2) + 4 * hi; }
#define MFMA32(a, b, c) __builtin_amdgcn_mfma_f32_32x32x16_bf16((a), (b), (c), 0, 0, 0)
#define LDSWAIT() asm volatile("s_waitcnt lgkmcnt(0)" ::: "memory")
__device__ __forceinline__ void sincos_rr(float ang, float& s, float& c) {
    const float k = rintf(ang * 0.15915494309189535f);
    float r = fmaf(-k, 6.2831854820251465f, ang);
    r = fmaf(-k, -1.7484556e-7f, r);
    s = __sinf(r); c = __cosf(r);
}
__device__ __forceinline__ float sigmoid_f(float x) { return 1.0f / (1.0f + expf(-x)); }

__device__ __forceinline__ void phase_mod(const Params& P, unsigned char* lds, int tid) {
    float* cond = (float*)lds; float* red = cond + 4096;
    const float* c = (const float*)kin(1); const float* w_ada = (const float*)kin(3); const float* b_ada = (const float*)kin(4);
    float* mod = (float*)(kws() + WS_MOD);
    for (int i = tid; i < 4096; i += 512) { const float v = c[i]; cond[i] = v / (1.0f + expf(-v)); }
    __syncthreads();
    const int ks = tid >> 4, cq = tid & 15;
    for (int item = blockIdx.x; item < 576; item += gridDim.x) {
        const int l = item / 144, n0 = (item % 144) * 64;
        const float* W = w_ada + (size_t)l * 1024 * 9216 + (size_t)(ks * 32) * 9216 + n0 + 4 * cq;
        f32x4 a0 = {0.f, 0.f, 0.f, 0.f}, a1 = a0, a2 = a0, a3 = a0;
        f32x4 wv[32];
#pragma unroll
        for (int k = 0; k < 32; ++k) wv[k] = *(const f32x4*)(W + (size_t)k * 9216);
#pragma unroll
        for (int k = 0; k < 32; ++k) { const int kk = ks * 32 + k; a0 += wv[k] * cond[kk]; a1 += wv[k] * cond[1024 + kk]; a2 += wv[k] * cond[2048 + kk]; a3 += wv[k] * cond[3072 + kk]; }
        *(f32x4*)(red + (ks * 4 + 0) * 64 + 4 * cq) = a0; *(f32x4*)(red + (ks * 4 + 1) * 64 + 4 * cq) = a1; *(f32x4*)(red + (ks * 4 + 2) * 64 + 4 * cq) = a2; *(f32x4*)(red + (ks * 4 + 3) * 64 + 4 * cq) = a3;
        __syncthreads();
        if (tid < 256) { const int b = tid >> 6, col = tid & 63; float sum = 0.f;
#pragma unroll
            for (int q = 0; q < 32; ++q) sum += red[(q * 4 + b) * 64 + col];
            mod[(size_t)(l * 4 + b) * 9216 + n0 + col] = sum + b_ada[l * 9216 + n0 + col]; }
        __syncthreads();
    }
}

__device__ __forceinline__ int srccol(int kind, int rho) {
    if (kind == 1) { const int G = rho >> 5, w = rho & 31; return w < 16 ? 16 * G + w : 2816 + 16 * G + (w - 16); }
    if (kind == 2) { return rho < 1824 ? rho : (rho < 2048 ? -1 : rho - 224); }
    return rho;
}
__device__ __forceinline__ void tr_item(const float* W, int K, int Nsrc, int Ndst, bf16_t* WT, int kind, float* scr, int item, int lane) {
    const int nblk = Ndst / 32, kb = item / nblk, nb = item % nblk, k0 = 64 * kb, n0 = 32 * nb;
    const int sc = srccol(kind, n0 + (lane & 31));
    float tv[32];
#pragma unroll
    for (int i = 0; i < 32; ++i) { const int kk = 2 * i + (lane >> 5); tv[i] = sc >= 0 ? W[(size_t)(k0 + kk) * Nsrc + sc] : 0.f; }
#pragma unroll
    for (int i = 0; i < 32; ++i) { const int kk = 2 * i + (lane >> 5); scr[kk * 33 + (lane & 31)] = tv[i]; }
    LDSWAIT();
    const int c = lane & 7;
#pragma unroll
    for (int j = 0; j < 4; ++j) { const int n = (lane >> 3) + 8 * j; const float* s = scr + (8 * c) * 33 + n;
        u32x4 o; o.x = pk2(s[0 * 33], s[1 * 33]); o.y = pk2(s[2 * 33], s[3 * 33]); o.z = pk2(s[4 * 33], s[5 * 33]); o.w = pk2(s[6 * 33], s[7 * 33]);
        *(u32x4*)(WT + (size_t)(n0 + n) * K + k0 + 8 * c) = o; }
    LDSWAIT();
}
__device__ __forceinline__ void convert_weights(const Params& P, int l, unsigned char* lds, int gw, int NGW, int wave, int lane) {
    float* scr = (float*)(lds + wave * 16384);
    unsigned char* wb = kws() + WS_WBF;
    constexpr int I_W1 = 16 * 176, I_W2 = 44 * 32, I_IN = 16 * 96, I_OUT = 16 * 32, I_UQ = 6 * 24, I_UKV = 4 * 32;
    constexpr int I_LO = 8, I_LG = 16;
    constexpr int NIT = 2 * I_W1 + 2 * I_W2 + I_IN + I_OUT + I_UQ + I_UKV + 4 * I_LO + I_LG;
    for (int it = gw; it < NIT; it += NGW) {
        int r = it;
        if (r < I_W1) { tr_item((const float*)kin(5) + (size_t)l * 1024 * 5632, 1024, 5632, 5632, (bf16_t*)(wb + WB_W1A), 1, scr, r, lane); continue; } r -= I_W1;
        if (r < I_W2) { tr_item((const float*)kin(6) + (size_t)l * 2816 * 1024, 2816, 1024, 1024, (bf16_t*)(wb + WB_W2A), 0, scr, r, lane); continue; } r -= I_W2;
        if (r < I_W1) { tr_item((const float*)kin(7) + (size_t)l * 1024 * 5632, 1024, 5632, 5632, (bf16_t*)(wb + WB_W1B), 1, scr, r, lane); continue; } r -= I_W1;
        if (r < I_W2) { tr_item((const float*)kin(8) + (size_t)l * 2816 * 1024, 2816, 1024, 1024, (bf16_t*)(wb + WB_W2B), 0, scr, r, lane); continue; } r -= I_W2;
        if (r < I_IN) { tr_item((const float*)kin(9) + (size_t)l * 1024 * 2848, 1024, 2848, 3072, (bf16_t*)(wb + WB_WIN), 2, scr, r, lane); continue; } r -= I_IN;
        if (r < I_OUT) { tr_item((const float*)kin(10) + (size_t)l * 1024 * 1024, 1024, 1024, 1024, (bf16_t*)(wb + WB_WOUT), 0, scr, r, lane); continue; } r -= I_OUT;
        if (r < I_UQ) { tr_item((const float*)kin(23) + (size_t)l * 384 * 768, 384, 768, 768, (bf16_t*)(wb + WB_WUQ), 0, scr, r, lane); continue; } r -= I_UQ;
        if (r < I_UKV) { tr_item((const float*)kin(25) + (size_t)l * 256 * 1024, 256, 1024, 1024, (bf16_t*)(wb + WB_WUKV), 0, scr, r, lane); continue; } r -= I_UKV;
        if (r < 2 * I_LO) { const int d = r / I_LO; tr_item((const float*)kin(13) + (size_t)(l * 2 + d) * 64 * 256, 64, 256, 256, (bf16_t*)(wb + WB_LWUP) + d * 256 * 64, 0, scr, r % I_LO, lane); continue; } r -= 2 * I_LO;
        if (r < 2 * I_LO) { const int d = r / I_LO; tr_item((const float*)kin(15) + (size_t)(l * 2 + d) * 64 * 256, 64, 256, 256, (bf16_t*)(wb + WB_LAUP) + d * 256 * 64, 0, scr, r % I_LO, lane); continue; } r -= 2 * I_LO;
        tr_item((const float*)kin(16) + (size_t)l * 128 * 256, 128, 256, 256, (bf16_t*)(wb + WB_LGUP), 0, scr, r, lane);
    }
}

__device__ __forceinline__ void norm_rows(const Params& P, const float* src, float* copy_dst, int l, int shi, int gw, int NGW, int lane) {
    const float* modl = (const float*)(kws() + WS_MOD) + (size_t)l * 4 * 9216;
    bf16_t* H = (bf16_t*)(kws() + WS_H);
    for (int m0 = 2 * gw; m0 < T; m0 += 2 * NGW) {
        f32x4 v[2][4]; float s[2] = {0.f, 0.f};
#pragma unroll
        for (int q = 0; q < 2; ++q) { const f32x4* xr = (const f32x4*)(src + (size_t)(m0 + q) * D) + lane;
#pragma unroll
            for (int j = 0; j < 4; ++j) v[q][j] = xr[64 * j]; }
#pragma unroll
        for (int q = 0; q < 2; ++q) {
#pragma unroll
            for (int j = 0; j < 4; ++j) s[q] += (v[q][j].x * v[q][j].x + v[q][j].y * v[q][j].y) + (v[q][j].z * v[q][j].z + v[q][j].w * v[q][j].w); }
#pragma unroll
        for (int q = 0; q < 2; ++q) {
            const int m = m0 + q, b = m >> 12;
            const float rstd = 1.0f / sqrtf(wave_sum(s[q]) * (1.0f / D) + 1e-6f);
            const f32x4* sh = (const f32x4*)(modl + (size_t)b * 9216 + shi * 1024) + lane;
            const f32x4* sc = (const f32x4*)(modl + (size_t)b * 9216 + (shi + 1) * 1024) + lane;
            u32x2* o8 = (u32x2*)(H + (size_t)m * D) + lane;
#pragma unroll
            for (int j = 0; j < 4; ++j) { const f32x4 a = sh[64 * j], c = sc[64 * j]; const f32x4 o = v[q][j] * rstd * (c + 1.0f) + a;
                u32x2 w; w.x = pk2(o.x, o.y); w.y = pk2(o.z, o.w); o8[64 * j] = w; }
            if (copy_dst) { f32x4* cd = (f32x4*)(copy_dst + (size_t)m * D) + lane;
#pragma unroll
                for (int j = 0; j < 4; ++j) cd[64 * j] = v[q][j]; }
        }
    }
}
__device__ __forceinline__ void final_norm(const Params& P, int gw, int NGW, int lane) {
    const float* g = (const float*)kin(28);
    for (int m0 = 2 * gw; m0 < T; m0 += 2 * NGW) {
        f32x4 v[2][4]; float s[2] = {0.f, 0.f};
#pragma unroll
        for (int q = 0; q < 2; ++q) { const f32x4* xr = (const f32x4*)(kout() + (size_t)(m0 + q) * D) + lane;
#pragma unroll
            for (int j = 0; j < 4; ++j) v[q][j] = xr[64 * j]; }
#pragma unroll
        for (int q = 0; q < 2; ++q) {
#pragma unroll
            for (int j = 0; j < 4; ++j) s[q] += (v[q][j].x * v[q][j].x + v[q][j].y * v[q][j].y) + (v[q][j].z * v[q][j].z + v[q][j].w * v[q][j].w); }
#pragma unroll
        for (int q = 0; q < 2; ++q) {
            f32x4* xr = (f32x4*)(kout() + (size_t)(m0 + q) * D) + lane;
            const float rstd = 1.0f / sqrtf(wave_sum(s[q]) * (1.0f / D) + 1e-6f);
#pragma unroll
            for (int j = 0; j < 4; ++j) { const f32x4 gg = ((const f32x4*)g)[lane + 64 * j]; xr[64 * j] = v[q][j] * rstd * gg; }
        }
    }
}

constexpr int ZL = 392;
__device__ __forceinline__ void rwkv_prep(const Params& P, int l, unsigned char* lds, int tid) {
    bf16_t* zl = (bf16_t*)lds;
    float* kl = (float*)(lds + 64 * ZL * 2);
    const float* ZF = (const float*)(kws() + WS_ZF);
    float* RKV = (float*)(kws() + WS_RKV); float* DEC = (float*)(kws() + WS_DEC); float* KKA = (float*)(kws() + WS_KKA); float* KMOD = (float*)(kws() + WS_KMOD);
    float* KK = (float*)(kws() + WS_KK); float* G = (float*)(kws() + WS_G);
    const float* mu = (const float*)kin(11) + l * 1152;
    const float* w0 = (const float*)kin(12) + l * 512; const float* a0 = (const float*)kin(14) + l * 512;
    const float* k_k = (const float*)kin(17) + l * 256; const float* k_a = (const float*)kin(18) + l * 256;
    const bf16_t* WUP = (const bf16_t*)(kws() + WS_WBF + WB_LWUP); const bf16_t* AUP = (const bf16_t*)(kws() + WS_WBF + WB_LAUP); const bf16_t* GUP = (const bf16_t*)(kws() + WS_WBF + WB_LGUP);
    for (int tile = blockIdx.x; tile < T / 64; tile += gridDim.x) {
        LAUNDER_V(tid);
        const int lane = tid & 63, wid = tid >> 6, r32 = lane & 31, hi = lane >> 5, h = wid & 3, th = wid >> 2;
        const int t0 = tile * 64, s0 = t0 & (S - 1);
#pragma unroll 4
        for (int idx = tid; idx < 64 * 288; idx += 512) {
            const int row = idx / 288, c4 = idx % 288, t = t0 + row, s = s0 + row;
            const f32x4 z = *(const f32x4*)(ZF + (size_t)t * 2048 + 4 * c4);
            f32x4 pv = {0.f, 0.f, 0.f, 0.f}, nx = {0.f, 0.f, 0.f, 0.f};
            if (s > 0) pv = *(const f32x4*)(ZF + (size_t)(t - 1) * 2048 + 4 * c4);
            if (s < S - 1) nx = *(const f32x4*)(ZF + (size_t)(t + 1) * 2048 + 4 * c4);
            const f32x4 m4 = *(const f32x4*)(mu + 4 * c4);
            f32x4 v = z + m4 * ((pv + nx) * 0.5f - z);
            const int col = 4 * c4;
            if (col < 768) {
                *(f32x4*)(RKV + (size_t)t * 768 + col) = v;
                if (col >= 256 && col < 512) *(f32x4*)(kl + row * 256 + (col - 256)) = v;
            } else {
                if (col < 896) { v.x = sigmoid_f(v.x); v.y = sigmoid_f(v.y); v.z = sigmoid_f(v.z); v.w = sigmoid_f(v.w); }
                else if (col < 1024) { v.x = tanhf(v.x); v.y = tanhf(v.y); v.z = tanhf(v.z); v.w = tanhf(v.w); }
                u32x2 w; w.x = pk2(v.x, v.y); w.y = pk2(v.z, v.w);
                *(u32x2*)(zl + row * ZL + (col - 768)) = w;
            }
        }
        __syncthreads();
        const bf16_t* za = zl + (32 * th + r32) * ZL + 8 * hi;
        const int cA = h * 64 + r32;
        float kinv[16];
        const float kk_c0 = k_k[cA], kk_c1 = k_k[cA + 32];
#pragma unroll
        for (int r = 0; r < 16; ++r) { const int tok = 32 * th + crow(r, hi); const float x0 = kl[tok * 256 + cA] * kk_c0, x1 = kl[tok * 256 + cA + 32] * kk_c1;
            const float nrm = sqrtf(half_sum(x0 * x0 + x1 * x1)); kinv[r] = 1.0f / fmaxf(nrm, 1e-12f);
            const unsigned t = (unsigned)(t0 + tok); KK[t * 256 + cA] = x0 * kinv[r]; KK[t * 256 + cA + 32] = x1 * kinv[r]; __builtin_amdgcn_sched_barrier(0); }
        const float ka0 = k_a[cA], ka1 = k_a[cA + 32];
#pragma unroll 1
        for (int d = 0; d < 2; ++d) {
            int dl = d; asm volatile("" : "+s"(dl));
            int t0l = t0; asm volatile("" : "+s"(t0l));
            { f32x16 c0, c1;
#pragma unroll
              for (int i = 0; i < 16; ++i) { c0[i] = 0.f; c1[i] = 0.f; }
              const bf16_t* wt = WUP + (size_t)dl * 256 * 64;
#pragma unroll
              for (int s = 0; s < 4; ++s) { const bf16x8 a = *(const bf16x8*)(za + 128 + dl * 64 + 16 * s);
                  const bf16x8 b0 = *(const bf16x8*)(wt + (size_t)cA * 64 + 16 * s + 8 * hi), b1 = *(const bf16x8*)(wt + (size_t)(cA + 32) * 64 + 16 * s + 8 * hi);
                  c0 = MFMA32(a, b0, c0); c1 = MFMA32(a, b1, c1); }
              const float wb0 = w0[dl * 256 + cA], wb1 = w0[dl * 256 + cA + 32];
#pragma unroll
              for (int r = 0; r < 16; ++r) { const unsigned t = (unsigned)(dl * T + t0l + 32 * th + crow(r, hi));
                  DEC[t * 256 + cA] = expf(-0.6065306597126334f * sigmoid_f(wb0 + c0[r])); DEC[t * 256 + cA + 32] = expf(-0.6065306597126334f * sigmoid_f(wb1 + c1[r])); __builtin_amdgcn_sched_barrier(0); } }
            { f32x16 c0, c1;
#pragma unroll
              for (int i = 0; i < 16; ++i) { c0[i] = 0.f; c1[i] = 0.f; }
              const bf16_t* wt = AUP + (size_t)dl * 256 * 64;
#pragma unroll
              for (int s = 0; s < 4; ++s) { const bf16x8 a = *(const bf16x8*)(za + 256 + dl * 64 + 16 * s);
                  const bf16x8 b0 = *(const bf16x8*)(wt + (size_t)cA * 64 + 16 * s + 8 * hi), b1 = *(const bf16x8*)(wt + (size_t)(cA + 32) * 64 + 16 * s + 8 * hi);
                  c0 = MFMA32(a, b0, c0); c1 = MFMA32(a, b1, c1); }
              const float ab0 = a0[dl * 256 + cA], ab1 = a0[dl * 256 + cA + 32];
#pragma unroll
              for (int r = 0; r < 16; ++r) { const unsigned t = (unsigned)(dl * T + t0l + 32 * th + crow(r, hi));
                  const float ad0 = sigmoid_f(ab0 + c0[r]), ad1 = sigmoid_f(ab1 + c1[r]);
                  const int tok = 32 * th + crow(r, hi); const float kq0 = kl[tok * 256 + cA], kq1 = kl[tok * 256 + cA + 32];
                  KKA[t * 256 + cA] = -(kq0 * kk_c0 * kinv[r] * ad0); KKA[t * 256 + cA + 32] = -(kq1 * kk_c1 * kinv[r] * ad1);
                  KMOD[t * 256 + cA] = kq0 * (1.0f + (ad0 - 1.0f) * ka0); KMOD[t * 256 + cA + 32] = kq1 * (1.0f + (ad1 - 1.0f) * ka1); __builtin_amdgcn_sched_barrier(0); } }
        }
        { f32x16 c0, c1;
#pragma unroll
          for (int i = 0; i < 16; ++i) { c0[i] = 0.f; c1[i] = 0.f; }
#pragma unroll
          for (int s = 0; s < 8; ++s) { const bf16x8 a = *(const bf16x8*)(za + 16 * s);
              const bf16x8 b0 = *(const bf16x8*)(GUP + (size_t)cA * 128 + 16 * s + 8 * hi), b1 = *(const bf16x8*)(GUP + (size_t)(cA + 32) * 128 + 16 * s + 8 * hi);
              c0 = MFMA32(a, b0, c0); c1 = MFMA32(a, b1, c1); }
#pragma unroll
          for (int r = 0; r < 16; ++r) { const unsigned t = (unsigned)(t0 + 32 * th + crow(r, hi)); G[t * 256 + cA] = c0[r]; G[t * 256 + cA + 32] = c1[r]; __builtin_amdgcn_sched_barrier(0); } }
        __syncthreads();
    }
}

__device__ __forceinline__ void mla_prep(const Params& P, int l, int gw, int NGW, int lane) {
    const float* ZF = (const float*)(kws() + WS_ZF); const int* pos = (const int*)kin(2);
    bf16_t* CQN = (bf16_t*)(kws() + WS_CQN); bf16_t* CKVN = (bf16_t*)(kws() + WS_CKVN); bf16_t* KPE = (bf16_t*)(kws() + WS_KPE);
    const float* qg = (const float*)kin(22) + l * 384; const float* kg = (const float*)kin(24) + l * 256;
    for (int mm = 2 * gw; mm < T; mm += 2 * NGW) {
        float q[2][6], kv[2][4], t1[2], t2[2]; int ps[2];
#pragma unroll
        for (int u = 0; u < 2; ++u) { const float* row = ZF + (size_t)(mm + u) * 2048;
#pragma unroll
            for (int j = 0; j < 6; ++j) q[u][j] = row[1152 + lane + 64 * j];
#pragma unroll
            for (int j = 0; j < 4; ++j) kv[u][j] = row[1536 + lane + 64 * j];
            t1[u] = row[1792 + (lane & 15)]; t2[u] = row[1808 + (lane & 15)]; ps[u] = pos[mm + u]; }
#pragma unroll
        for (int u = 0; u < 2; ++u) {
            const int m = mm + u;
            float s = 0.f;
#pragma unroll
            for (int j = 0; j < 6; ++j) s += q[u][j] * q[u][j];
            float rstd = 1.0f / sqrtf(wave_sum(s) * (1.0f / 384.0f) + 1e-6f);
#pragma unroll
            for (int j = 0; j < 6; ++j) CQN[(size_t)m * 384 + lane + 64 * j] = (bf16_t)(pk2(q[u][j] * rstd * qg[lane + 64 * j], 0.f) & 0xffffu);
            s = 0.f;
#pragma unroll
            for (int j = 0; j < 4; ++j) s += kv[u][j] * kv[u][j];
            rstd = 1.0f / sqrtf(wave_sum(s) * (1.0f / 256.0f) + 1e-6f);
#pragma unroll
            for (int j = 0; j < 4; ++j) CKVN[(size_t)m * 256 + lane + 64 * j] = (bf16_t)(pk2(kv[u][j] * rstd * kg[lane + 64 * j], 0.f) & 0xffffu);
            if (lane < 16) {
                const float inv = exp2f(-(float)lane * (LOG2_1E4 / 16.0f));
                float sn, cs; sincos_rr((float)ps[u] * inv, sn, cs);
                KPE[(size_t)m * 32 + lane] = (bf16_t)(pk2(t1[u] * cs - t2[u] * sn, 0.f) & 0xffffu);
                KPE[(size_t)m * 32 + 16 + lane] = (bf16_t)(pk2(t2[u] * cs + t1[u] * sn, 0.f) & 0xffffu);
            }
        }
    }
}

constexpr int RS = 136;
__device__ __forceinline__ void ret_state(const Params& P, int l, unsigned char* lds, int tid) {
    bf16_t* Ktf = (bf16_t*)lds; bf16_t* Ktb = Ktf + 64 * RS; bf16_t* Vt = Ktb + 64 * RS;
    bf16_t* ZR = (bf16_t*)(kws() + WS_ZR); float* KVT = (float*)(kws() + WS_KVT);
    const int* pos = (const int*)kin(2); const float* lr = (const float*)kin(26) + l * 8;
    for (int u = blockIdx.x; u < 512; u += gridDim.x) {
        LAUNDER_V(tid);
        const int lane = tid & 63, wid = tid >> 6, r32 = lane & 31, hi = lane >> 5;
        const int b = u >> 7, h = (u >> 5) & 3, n = u & 31;
        const float lgf2 = -expf(lr[h]) * LOG2E, lgb2 = -expf(lr[4 + h]) * LOG2E;
        const size_t t0 = (size_t)b * S + n * 128;
        {
            const int c = tid & 127, i8 = tid >> 7;
            bf16_t* row = ZR + (t0 + c) * 1024 + h * 64;
            const u32x4 qlo = *(const u32x4*)(row + 8 * i8), qhi = *(const u32x4*)(row + 32 + 8 * i8);
            const u32x4 klo = *(const u32x4*)(row + 256 + 8 * i8), khi = *(const u32x4*)(row + 256 + 32 + 8 * i8);
            const float p = (float)pos[t0 + c];
            const float wf = exp2f(lgf2 * (float)(127 - c)), wb = exp2f(lgb2 * (float)c);
            u32x4 oql, oqh, okl, okh;
#pragma unroll
            for (int jj = 0; jj < 4; ++jj) {
                float ql[2], qh[2], kl[2], kh[2], nql[2], nqh[2], nkl[2], nkh[2];
                ql[0] = bf2f((unsigned short)(qlo[jj] & 0xffffu)); ql[1] = bf2f((unsigned short)(qlo[jj] >> 16));
                qh[0] = bf2f((unsigned short)(qhi[jj] & 0xffffu)); qh[1] = bf2f((unsigned short)(qhi[jj] >> 16));
                kl[0] = bf2f((unsigned short)(klo[jj] & 0xffffu)); kl[1] = bf2f((unsigned short)(klo[jj] >> 16));
                kh[0] = bf2f((unsigned short)(khi[jj] & 0xffffu)); kh[1] = bf2f((unsigned short)(khi[jj] >> 16));
#pragma unroll
                for (int e = 0; e < 2; ++e) {
                    const int i = 8 * i8 + 2 * jj + e;
                    const float inv = exp2f(-(float)i * (LOG2_1E4 / 32.0f));
                    float sn, cs; sincos_rr(p * inv, sn, cs);
                    nql[e] = ql[e] * cs - qh[e] * sn; nqh[e] = qh[e] * cs + ql[e] * sn;
                    nkl[e] = (kl[e] * cs - kh[e] * sn) * 0.125f; nkh[e] = (kh[e] * cs + kl[e] * sn) * 0.125f;
                    Ktf[i * RS + c] = (bf16_t)(pk2(nkl[e] * wf, 0.f) & 0xffffu); Ktf[(32 + i) * RS + c] = (bf16_t)(pk2(nkh[e] * wf, 0.f) & 0xffffu);
                    Ktb[i * RS + c] = (bf16_t)(pk2(nkl[e] * wb, 0.f) & 0xffffu); Ktb[(32 + i) * RS + c] = (bf16_t)(pk2(nkh[e] * wb, 0.f) & 0xffffu);
                }
                oql[jj] = pk2(nql[0], nql[1]); oqh[jj] = pk2(nqh[0], nqh[1]); okl[jj] = pk2(nkl[0], nkl[1]); okh[jj] = pk2(nkh[0], nkh[1]);
            }
            *(u32x4*)(row + 8 * i8) = oql; *(u32x4*)(row + 32 + 8 * i8) = oqh; *(u32x4*)(row + 256 + 8 * i8) = okl; *(u32x4*)(row + 256 + 32 + 8 * i8) = okh;
#pragma unroll
            for (int it = 0; it < 2; ++it) {
                const int idx = tid + 512 * it, key = idx & 127, e8 = (idx >> 7) * 8;
                const u32x4 v = *(const u32x4*)(ZR + (t0 + key) * 1024 + 512 + h * 64 + e8);
#pragma unroll
                for (int i = 0; i < 8; ++i) Vt[(e8 + i) * RS + key] = (bf16_t)((v[i >> 1] >> (16 * (i & 1))) & 0xffffu);
            }
        }
        __syncthreads();
        {
            const int dir = wid >> 2, eb = (wid >> 1) & 1, db = wid & 1;
            const bf16_t* Kw = dir ? Ktb : Ktf;
            f32x16 acc;
#pragma unroll
            for (int i = 0; i < 16; ++i) acc[i] = 0.f;
#pragma unroll
            for (int s = 0; s < 8; ++s) {
                const bf16x8 a = *(const bf16x8*)(Vt + (32 * eb + r32) * RS + 16 * s + 8 * hi);
                const bf16x8 bb = *(const bf16x8*)(Kw + (32 * db + r32) * RS + 16 * s + 8 * hi);
                acc = MFMA32(a, bb, acc);
            }
            float* o = KVT + ((size_t)u * 2 + dir) * 4096;
#pragma unroll
            for (int r = 0; r < 16; ++r) o[(32 * eb + crow(r, hi)) * 64 + 32 * db + r32] = acc[r];
        }
        __syncthreads();
    }
}
__device__ __forceinline__ void ret_scan(const Params& P, int l, int tid) {
    const float* KVT = (const float*)(kws() + WS_KVT); bf16_t* RT = (bf16_t*)(kws() + WS_RT);
    const float* lr = (const float*)kin(26) + l * 8;
    for (int g = blockIdx.x * 512 + tid; g < 16 * 2 * 4096; g += gridDim.x * 512) {
        const int idx = g & 4095, dir = (g >> 12) & 1, bh = g >> 13, h = bh & 3;
        const float dc = expf(-expf(lr[dir * 4 + h]) * 128.0f);
        float kv[32];
#pragma unroll
        for (int n = 0; n < 32; ++n) kv[n] = KVT[((size_t)(bh * 32 + n) * 2 + dir) * 4096 + idx];
        float R = 0.f;
        if (dir == 0) {
#pragma unroll
            for (int n = 0; n < 32; ++n) { const size_t o = ((size_t)(bh * 32 + n) * 2 + 0) * 4096 + idx; RT[o] = (bf16_t)(pk2(R, 0.f) & 0xffffu); R = R * dc + kv[n]; } }
        else {
#pragma unroll
            for (int n = 31; n >= 0; --n) { const size_t o = ((size_t)(bh * 32 + n) * 2 + 1) * 4096 + idx; RT[o] = (bf16_t)(pk2(R, 0.f) & 0xffffu); R = R * dc + kv[n]; } }
    }
}

template <int CTRL> __device__ __forceinline__ float dpp_add(float x) { const int y = __builtin_amdgcn_update_dpp(0, __float_as_int(x), CTRL, 0xf, 0xf, false); return x + __int_as_float(y); }
__device__ __forceinline__ float row16_sum(float x) { x = dpp_add<0x128>(x); x = dpp_add<0x124>(x); x = dpp_add<0x122>(x); x = dpp_add<0x121>(x); return x; }
constexpr int SC_CH = 16, SC_BUF = SC_CH * (5 * 64 + 16), SC_YP = SC_CH * 64, SC_NB = 5;
template <int DIR> __device__ __forceinline__ void rwkv_scan_dir(const Params& P, unsigned char* lds, int sb, int tid) {
    float* buf = (float*)lds;
    float* ypart = buf + SC_NB * SC_BUF + 1024;
    const float* DEC = (const float*)(kws() + WS_DEC) + (size_t)DIR * T * 256; const float* KKA = (const float*)(kws() + WS_KKA) + (size_t)DIR * T * 256;
    const float* KMOD = (const float*)(kws() + WS_KMOD) + (size_t)DIR * T * 256; const float* KK = (const float*)(kws() + WS_KK); const float* RKV = (const float*)(kws() + WS_RKV);
    float* Y = (float*)(kws() + WS_Y) + (size_t)DIR * T * 256;
    const int chain = sb >> 2, rq = sb & 3, b = (chain >> 2) & 3, h = chain & 3;
    const int cbase = h * 64;
    const size_t row0 = (size_t)b * S;
    const int wid = tid >> 6, lane = tid & 63;
    const bool loader = wid >= 4;
    const int grp = wid - 4;
    const int ltid = tid - 256;
    f32x4 lr_[20], lv;
#define SC_LOAD(ck) do { _Pragma("unroll") for (int i = 0; i < 20; ++i) { const int wi = lane + 64 * (i & 3), st = wi >> 4, q4 = wi & 15; const int s = (ck) * SC_CH + st; const size_t gr = row0 + (DIR ? (S - 1 - s) : s); \
        const float* src_ = (i >> 2) == 0 ? DEC + gr * 256 : (i >> 2) == 1 ? KK + gr * 256 : (i >> 2) == 2 ? KKA + gr * 256 : (i >> 2) == 3 ? KMOD + gr * 256 : RKV + gr * 768; \
        lr_[i] = *(const f32x4*)(src_ + cbase + 4 * q4); } \
        { const int st = lane >> 2, q4 = lane & 3; const int s = (ck) * SC_CH + st; const size_t gr = row0 + (DIR ? (S - 1 - s) : s); lv = *(const f32x4*)(RKV + gr * 768 + 512 + cbase + rq * 16 + 4 * q4); } } while (0)
#define SC_STORE(ck) do { float* B_ = buf + ((ck) % SC_NB) * SC_BUF; _Pragma("unroll") for (int i = 0; i < 20; ++i) { const int wi = lane + 64 * (i & 3), st = wi >> 4, q4 = wi & 15; \
        *(f32x4*)(B_ + st * 336 + (i >> 2) * 64 + 4 * q4) = lr_[i]; } \
        { const int st = lane >> 2, q4 = lane & 3; *(f32x4*)(B_ + st * 336 + 320 + 4 * q4) = lv; } } while (0)
#define SC_YOUT(ck) do { const float* yp_ = ypart + ((ck) & 1) * SC_YP; const int st = ltid >> 4, rw = ltid & 15; \
        const f32x4 q_ = *(const f32x4*)(yp_ + ltid * 4); const int s = (ck) * SC_CH + st; const size_t gr = row0 + (DIR ? (S - 1 - s) : s); \
        Y[gr * 256 + cbase + rq * 16 + rw] = (q_.x + q_.y) + (q_.z + q_.w); } while (0)
    constexpr int NCH = S / SC_CH;
    if (loader) { SC_LOAD(grp); if (grp == 0) { SC_STORE(0); SC_LOAD(4); } }
    __syncthreads();
    const int rowi = (wid & 3) * 4 + (lane >> 4), j = lane & 15;
    f32x2 sA = {0.f, 0.f}, sB = {0.f, 0.f};
    for (int ck = 0; ck < NCH; ++ck) {
        if (loader) {
            if (ck + 1 < NCH && ((ck + 1) & 3) == grp) { SC_STORE(ck + 1); if (ck + 5 < NCH) SC_LOAD(ck + 5); }
            if (ck > 0) SC_YOUT(ck - 1);
        } else {
            const float* rp = buf + (ck % SC_NB) * SC_BUF + 4 * j;
            const float* vp = buf + (ck % SC_NB) * SC_BUF + 320 + rowi;
            int yoff = (ck & 1) * SC_YP + rowi * 4 + (j & 3); LAUNDER_V(yoff);
            float* yp = ypart + yoff;
            f32x4 w = *(const f32x4*)(rp), kk = *(const f32x4*)(rp + 64), kka = *(const f32x4*)(rp + 128), km = *(const f32x4*)(rp + 192), r = *(const f32x4*)(rp + 256);
            float v = *vp;
            f32x4 w1 = *(const f32x4*)(rp + 336), kk1 = *(const f32x4*)(rp + 336 + 64), kka1 = *(const f32x4*)(rp + 336 + 128), km1 = *(const f32x4*)(rp + 336 + 192), r1 = *(const f32x4*)(rp + 336 + 256);
            float v1 = vp[336];
#define LO2(x) __builtin_shufflevector(x, x, 0, 1)
#define HI2(x) __builtin_shufflevector(x, x, 2, 3)
#pragma unroll 8
            for (int st = 0; st < SC_CH; ++st) {
                const float* rn = rp + (st + 2) * 336;
                const f32x4 nw = *(const f32x4*)(rn), nkk = *(const f32x4*)(rn + 64), nkka = *(const f32x4*)(rn + 128), nkm = *(const f32x4*)(rn + 192), nr = *(const f32x4*)(rn + 256);
                const float nv = vp[(st + 2) * 336];
                f32x2 q = sA * LO2(kk); q = sB * HI2(kk) + q;
                float sk = q.x + q.y;
                float yy = 0.f;
                if (DIR == 1) { f32x2 yq = sA * LO2(r); yq = sB * HI2(r) + yq; yy = yq.x + yq.y; }
                sk = row16_sum(sk);
                f32x2 tA = LO2(km) * v, tB = HI2(km) * v;
                tA = sA * LO2(w) + tA; tB = sB * HI2(w) + tB;
                sA = LO2(kka) * sk + tA; sB = HI2(kka) * sk + tB;
                if (DIR == 0) { f32x2 yq = sA * LO2(r); yq = sB * HI2(r) + yq; yy = yq.x + yq.y; }
                yy = dpp_add<0x128>(yy); yy = dpp_add<0x124>(yy);
                yp[st * 64] = yy;
                w = w1; kk = kk1; kka = kka1; km = km1; r = r1; v = v1;
                w1 = nw; kk1 = nkk; kka1 = nkka; km1 = nkm; r1 = nr; v1 = nv;
            }
#undef LO2
#undef HI2
        }
        asm volatile("s_waitcnt lgkmcnt(0)\n\ts_barrier" ::: "memory");
    }
    if (loader) SC_YOUT(NCH - 1);
    __syncthreads();
#undef SC_LOAD
#undef SC_STORE
#undef SC_YOUT
}

__device__ __forceinline__ void rwkv_post(const Params& P, int l, int gw, int NGW, int lane) {
    const float* Y = (const float*)(kws() + WS_Y); const float* RKV = (const float*)(kws() + WS_RKV); const float* G = (const float*)(kws() + WS_G);
    bf16_t* MIX = (bf16_t*)(kws() + WS_H);
    const float* r_k = (const float*)kin(19) + l * 256; const float* ln_g = (const float*)kin(20) + l * 256; const float* ln_b = (const float*)kin(21) + l * 256;
    for (int it0 = gw; it0 < T * 4; it0 += 4 * NGW) {
        float y[4], r[4], k[4], v[4], g[4], lg[4], lb[4], rk[4];
#pragma unroll
        for (int q = 0; q < 4; ++q) { const int it = it0 + q * NGW; const size_t t = (size_t)(it >> 2); const int c = (it & 3) * 64 + lane;
            y[q] = Y[t * 256 + c] + Y[((size_t)T + t) * 256 + c]; r[q] = RKV[t * 768 + c]; k[q] = RKV[t * 768 + 256 + c]; v[q] = RKV[t * 768 + 512 + c]; g[q] = G[t * 256 + c];
            lg[q] = ln_g[c]; lb[q] = ln_b[c]; rk[q] = r_k[c]; }
#pragma unroll
        for (int q = 0; q < 4; ++q) { const int it = it0 + q * NGW; const size_t t = (size_t)(it >> 2); const int c = (it & 3) * 64 + lane;
            const float mean = wave_sum(y[q]) * (1.0f / 64.0f);
            const float dd = y[q] - mean;
            const float var = wave_sum(dd * dd) * (1.0f / 64.0f);
            const float yn = dd * (1.0f / sqrtf(var + 64e-5f)) * lg[q] + lb[q];
            const float bonus = wave_sum(r[q] * k[q] * rk[q]) * v[q];
            MIX[t * 1024 + c] = (bf16_t)(pk2((yn + bonus) * g[q], 0.f) & 0xffffu); }
    }
}

constexpr int AK = 104, AV = 72;
constexpr int AT_KB = 64 * AK * 2, AT_VB = 64 * AV * 2;
__device__ __forceinline__ float max3_asm(float a, float b, float c) { float r; asm("v_max3_f32 %0, %1, %2, %3" : "=v"(r) : "v"(a), "v"(b), "v"(c)); return r; }
__device__ __forceinline__ float max2_asm(float a, float b) { float r; asm("v_max_f32_e32 %0, %1, %2" : "=v"(r) : "v"(a), "v"(b)); return r; }
__device__ __forceinline__ float halves_max(float m) { auto rr = __builtin_amdgcn_permlane32_swap(__float_as_uint(m), __float_as_uint(m), false, false); return max2_asm(__uint_as_float(rr[0]), __uint_as_float(rr[1])); }
constexpr float ATT_THR = 12.0f;
__device__ __forceinline__ void attn_unit(const Params& P, unsigned char* lds, int b, int h, int qb, int tid) {
    const int lane = tid & 63, r32 = lane & 31, hi = lane >> 5, wid = tid >> 6;
    float* wsf = (float*)(lds + 2 * AT_KB + 2 * AT_VB) + wid * 64;
    const bf16_t* QB = (const bf16_t*)(kws() + WS_QB); const bf16_t* KVB = (const bf16_t*)(kws() + WS_KVB); const bf16_t* KPE = (const bf16_t*)(kws() + WS_KPE);
    const bf16_t* VTg = (const bf16_t*)(kws() + WS_VT) + (size_t)((b * 8 + h) * 64) * 4096;
    bf16_t* MIX = (bf16_t*)(kws() + WS_H); const int* pos = (const int*)kin(2);
    const size_t row0 = (size_t)b * S;
    const int q0 = qb * 256 + wid * 32;
    bf16x8 qr[6];
    {
        const size_t qrow = row0 + q0 + r32;
        float qf[6][8];
#pragma unroll
        for (int s = 0; s < 6; ++s) { const bf16x8 raw = *(const bf16x8*)(QB + qrow * 768 + h * 96 + 16 * s + 8 * hi);
#pragma unroll
            for (int j = 0; j < 8; ++j) qf[s][j] = bf2f((unsigned short)raw[j]); }
        const float p = (float)pos[qrow];
#pragma unroll
        for (int j = 0; j < 8; ++j) { const float inv = exp2f(-(float)(8 * hi + j) * (LOG2_1E4 / 16.0f)); float sn, cs; sincos_rr(p * inv, sn, cs);
            const float t1 = qf[4][j], t2 = qf[5][j]; qf[4][j] = t1 * cs - t2 * sn; qf[5][j] = t2 * cs + t1 * sn; }
        const float C2 = 0.10206207261596577f * LOG2E;
#pragma unroll
        for (int s = 0; s < 6; ++s) { u32x4 w; w.x = pk2(qf[s][0] * C2, qf[s][1] * C2); w.y = pk2(qf[s][2] * C2, qf[s][3] * C2); w.z = pk2(qf[s][4] * C2, qf[s][5] * C2); w.w = pk2(qf[s][6] * C2, qf[s][7] * C2);
            qr[s] = __builtin_bit_cast(bf16x8, w); }
    }
    const int key0 = tid / 12, part0 = tid % 12, key1 = (512 + tid) / 12, part1 = (512 + tid) % 12;
    const int ve = tid >> 3, vpart = tid & 7;
    u32x4 kA, kB = {0u, 0u, 0u, 0u}, vR;
    const bf16_t* kp0 = part0 < 8 ? KVB + (row0 + key0) * 1024 + h * 128 + part0 * 8 : KPE + (row0 + key0) * 32 + (part0 - 8) * 8;
    const bf16_t* kp1 = part1 < 8 ? KVB + (row0 + key1) * 1024 + h * 128 + part1 * 8 : KPE + (row0 + key1) * 32 + (part1 - 8) * 8;
    const int ks0 = part0 < 8 ? 64 * 1024 : 64 * 32, ks1 = part1 < 8 ? 64 * 1024 : 64 * 32;
    const bf16_t* vp0 = VTg + (size_t)ve * 4096 + vpart * 8;
#define AT_LOADK(kt) do { kA = *(const u32x4*)(kp0 + (size_t)(kt) * ks0); if (tid < 256) kB = *(const u32x4*)(kp1 + (size_t)(kt) * ks1); } while (0)
#define AT_LOADV(kt) do { vR = *(const u32x4*)(vp0 + (kt) * 64); } while (0)
#define AT_STOREK(bi) do { bf16_t* Kw_ = (bf16_t*)(lds + (bi) * AT_KB); *(u32x4*)(Kw_ + key0 * AK + part0 * 8) = kA; if (tid < 256) *(u32x4*)(Kw_ + key1 * AK + part1 * 8) = kB; } while (0)
#define AT_STOREV(bi) do { bf16_t* Vw_ = (bf16_t*)(lds + 2 * AT_KB + (bi) * AT_VB); *(u32x4*)(Vw_ + ve * AV + vpart * 8) = vR; } while (0)
#define AT_QK(P0, P1, bi, CI) do { const bf16_t* Kt_ = (const bf16_t*)(lds + (bi) * AT_KB); P0 = CI; P1 = CI; \
        _Pragma("unroll") for (int s = 0; s < 6; ++s) { const bf16x8 a0_ = *(const bf16x8*)(Kt_ + r32 * AK + 16 * s + 8 * hi), a1_ = *(const bf16x8*)(Kt_ + (32 + r32) * AK + 16 * s + 8 * hi); \
            P0 = MFMA32(a0_, qr[s], P0); P1 = MFMA32(a1_, qr[s], P1); } } while (0)
    float mref, l_part = 0.f;
    f32x16 o0, o1, negm, sa0, sa1, sb0, sb1;
#pragma unroll
    for (int i = 0; i < 16; ++i) { o0[i] = 0.f; o1[i] = 0.f; negm[i] = 0.f; }
    AT_LOADK(0); AT_LOADV(0); AT_STOREK(0); AT_STOREV(0); AT_LOADK(1);
    __syncthreads();
    AT_QK(sa0, sa1, 0, negm);
    { float mx = fmaxf(sa0[0], sa1[0]);
#pragma unroll
      for (int i = 1; i < 16; ++i) mx = fmaxf(mx, fmaxf(sa0[i], sa1[i]));
      mx = fmaxf(mx, __shfl_xor(mx, 32));
      mref = mx;
#pragma unroll
      for (int i = 0; i < 16; ++i) { sa0[i] -= mx; sa1[i] -= mx; negm[i] = -mx; } }
    AT_STOREK(1); AT_LOADK(2); AT_LOADV(1);
    __syncthreads();
#define AT_STEP(C0, C1, N0, N1, kt) do { \
        if ((kt) + 2 < S / 64) AT_STOREK((kt) & 1); \
        if ((kt) + 1 < S / 64) AT_STOREV(((kt) + 1) & 1); \
        if ((kt) + 3 < S / 64) AT_LOADK((kt) + 3); \
        if ((kt) + 2 < S / 64) AT_LOADV((kt) + 2); \
        float mx_ = max3_asm(C0[0], C0[1], C1[0]); float my_ = max3_asm(C0[2], C0[3], C1[1]); mx_ = max3_asm(mx_, C1[2], C1[3]); \
        _Pragma("unroll") for (int i = 4; i < 16; i += 4) { mx_ = max3_asm(mx_, C0[i], C0[i + 1]); my_ = max3_asm(my_, C0[i + 2], C0[i + 3]); mx_ = max3_asm(mx_, C1[i], C1[i + 1]); my_ = max3_asm(my_, C1[i + 2], C1[i + 3]); } \
        mx_ = halves_max(max2_asm(mx_, my_)); \
        if (__builtin_expect(__any(mx_ > ATT_THR), 0)) { \
            const float dl_ = fmaxf(mx_, 0.f); mref += dl_; const float f_ = __builtin_amdgcn_exp2f(-dl_); l_part *= f_; \
            _Pragma("unroll") for (int i = 0; i < 16; ++i) { C0[i] -= dl_; C1[i] -= dl_; negm[i] = -mref; } \
            if (hi == 0) wsf[r32] = f_; \
            LDSWAIT(); \
            _Pragma("unroll") for (int r = 0; r < 16; ++r) { const float fr_ = wsf[crow(r, hi)]; o0[r] *= fr_; o1[r] *= fr_; } \
        } \
        if ((kt) + 1 < S / 64) AT_QK(N0, N1, ((kt) + 1) & 1, negm);     \
        float rs0_ = 0.f, rs1_ = 0.f, rs2_ = 0.f, rs3_ = 0.f; \
        _Pragma("unroll") for (int i = 0; i < 16; i += 4) { \
            C0[i] = __builtin_amdgcn_exp2f(C0[i]); C1[i] = __builtin_amdgcn_exp2f(C1[i]); rs0_ += C0[i] + C1[i]; \
            C0[i + 1] = __builtin_amdgcn_exp2f(C0[i + 1]); C1[i + 1] = __builtin_amdgcn_exp2f(C1[i + 1]); rs1_ += C0[i + 1] + C1[i + 1]; \
            C0[i + 2] = __builtin_amdgcn_exp2f(C0[i + 2]); C1[i + 2] = __builtin_amdgcn_exp2f(C1[i + 2]); rs2_ += C0[i + 2] + C1[i + 2]; \
            C0[i + 3] = __builtin_amdgcn_exp2f(C0[i + 3]); C1[i + 3] = __builtin_amdgcn_exp2f(C1[i + 3]); rs3_ += C0[i + 3] + C1[i + 3]; } \
        l_part += (rs0_ + rs1_) + (rs2_ + rs3_); \
        { const bf16_t* Vt_ = (const bf16_t*)(lds + 2 * AT_KB + ((kt) & 1) * AT_VB); \
          _Pragma("unroll") for (int kb = 0; kb < 2; ++kb) _Pragma("unroll") for (int hf = 0; hf < 2; ++hf) { \
            u32x4 w_; \
            if (kb == 0) { w_.x = pk2(C0[8 * hf + 0], C0[8 * hf + 1]); w_.y = pk2(C0[8 * hf + 2], C0[8 * hf + 3]); w_.z = pk2(C0[8 * hf + 4], C0[8 * hf + 5]); w_.w = pk2(C0[8 * hf + 6], C0[8 * hf + 7]); } \
            else { w_.x = pk2(C1[8 * hf + 0], C1[8 * hf + 1]); w_.y = pk2(C1[8 * hf + 2], C1[8 * hf + 3]); w_.z = pk2(C1[8 * hf + 4], C1[8 * hf + 5]); w_.w = pk2(C1[8 * hf + 6], C1[8 * hf + 7]); } \
            const bf16x8 A_ = __builtin_bit_cast(bf16x8, w_); \
            const int kofs_ = 32 * kb + 16 * hf + 8 * hi; \
            const bf16x8 B0_ = *(const bf16x8*)(Vt_ + r32 * AV + kofs_), B1_ = *(const bf16x8*)(Vt_ + (32 + r32) * AV + kofs_); \
            o0 = MFMA32(A_, B0_, o0); o1 = MFMA32(A_, B1_, o1); } } \
          \
        _Pragma("unroll") for (int g_ = 0; g_ < 12; ++g_) { __builtin_amdgcn_sched_group_barrier(0x008, 1, 0); __builtin_amdgcn_sched_group_barrier(0x100, 2, 0); __builtin_amdgcn_sched_group_barrier(0x002, 5, 0); } \
        _Pragma("unroll") for (int g_ = 0; g_ < 8; ++g_) { __builtin_amdgcn_sched_group_barrier(0x008, 1, 0); __builtin_amdgcn_sched_group_barrier(0x100, 1, 0); __builtin_amdgcn_sched_group_barrier(0x002, 4, 0); } \
        __syncthreads(); \
    } while (0)
    for (int kt = 0; kt < S / 64; kt += 2) {
        AT_STEP(sa0, sa1, sb0, sb1, kt);
        AT_STEP(sb0, sb1, sa0, sa1, kt + 1);
    }
    float l_run = l_part + __shfl_xor(l_part, 32);
    if (hi == 0) wsf[32 + r32] = l_run;
    LDSWAIT();
    int q0l = q0; LAUNDER_V(q0l);
#pragma unroll
    for (int r = 0; r < 16; ++r) {
        const float rl = 1.0f / wsf[32 + crow(r, hi)];
        bf16_t* orow = MIX + (row0 + q0l + crow(r, hi)) * 1024 + 256 + h * 64;
        orow[r32] = (bf16_t)(pk2(o0[r] * rl, 0.f) & 0xffffu); orow[32 + r32] = (bf16_t)(pk2(o1[r] * rl, 0.f) & 0xffffu);
    }
    LDSWAIT();
    __syncthreads();
#undef AT_LOADK
#undef AT_LOADV
#undef AT_STOREK
#undef AT_STOREV
#undef AT_QK
#undef AT_STEP
}

constexpr int RK = 72;
__device__ __forceinline__ void ret_out(const Params& P, int l, unsigned char* lds, int u, int tid) {
    const int lane = tid & 63, r32 = lane & 31, hi = lane >> 5, wid = tid >> 6;
    bf16_t* Kl = (bf16_t*)lds;
    bf16_t* Vt = Kl + 2 * 128 * RK;
    const bf16_t* ZR = (const bf16_t*)(kws() + WS_ZR); const bf16_t* RT = (const bf16_t*)(kws() + WS_RT); bf16_t* MIX = (bf16_t*)(kws() + WS_H);
    const float* lr = (const float*)kin(26) + l * 8; const float* gn = (const float*)kin(27) + l * 256;
    const int b = u >> 6, h = (u >> 4) & 3, np = u & 15;
    const float lgf2 = -expf(lr[h]) * LOG2E, lgb2 = -expf(lr[4 + h]) * LOG2E;
    const size_t t0 = (size_t)b * S + np * 256;
#pragma unroll
    for (int it = 0; it < 4; ++it) {
        const int idx = tid + 512 * it;
        { const int part = idx & 7, key = (idx >> 3) & 127, ck = idx >> 10;
          const u32x4 kv = *(const u32x4*)(ZR + (t0 + ck * 128 + key) * 1024 + 256 + h * 64 + part * 8);
          *(u32x4*)(Kl + (ck * 128 + key) * RK + part * 8) = kv; }
        { const int key = idx & 127, e8 = ((idx >> 7) & 7) * 8, ck = idx >> 10;
          const u32x4 v = *(const u32x4*)(ZR + (t0 + ck * 128 + key) * 1024 + 512 + h * 64 + e8);
#pragma unroll
          for (int i = 0; i < 8; ++i) Vt[(ck * 64 + e8 + i) * RS + key] = (bf16_t)((v[i >> 1] >> (16 * (i & 1))) & 0xffffu); }
    }
    __syncthreads();
    const int ck = wid >> 2, c0 = 32 * (wid & 3);
    const size_t tc = t0 + ck * 128;
    const int n = np * 2 + ck;
    bf16x8 qr[4];
#pragma unroll
    for (int s = 0; s < 4; ++s) qr[s] = *(const bf16x8*)(ZR + (tc + c0 + r32) * 1024 + h * 64 + 16 * s + 8 * hi);
    const bf16_t* Kc = Kl + ck * 128 * RK; const bf16_t* Vc = Vt + ck * 64 * RS;
    f32x16 o0, o1;
#pragma unroll
    for (int i = 0; i < 16; ++i) { o0[i] = 0.f; o1[i] = 0.f; }
    const int cq = c0 + r32;
#pragma unroll 1
    for (int kb = 0; kb < 4; ++kb) {
        f32x16 p;
#pragma unroll
        for (int i = 0; i < 16; ++i) p[i] = 0.f;
#pragma unroll
        for (int s = 0; s < 4; ++s) { const bf16x8 a = *(const bf16x8*)(Kc + (32 * kb + r32) * RK + 16 * s + 8 * hi); p = MFMA32(a, qr[s], p); }
#pragma unroll
        for (int r = 0; r < 16; ++r) { const int mkey = 32 * kb + crow(r, hi); const int df = cq - mkey;
            const float wgt = df >= 0 ? __builtin_amdgcn_exp2f(lgf2 * (float)df) : __builtin_amdgcn_exp2f(lgb2 * (float)(-df)); p[r] *= wgt; }
#pragma unroll
        for (int hf = 0; hf < 2; ++hf) {
            u32x4 w; w.x = pk2(p[8 * hf + 0], p[8 * hf + 1]); w.y = pk2(p[8 * hf + 2], p[8 * hf + 3]); w.z = pk2(p[8 * hf + 4], p[8 * hf + 5]); w.w = pk2(p[8 * hf + 6], p[8 * hf + 7]);
            const bf16x8 A = __builtin_bit_cast(bf16x8, w);
            const int kofs = 32 * kb + 16 * hf + 4 * hi;
            const s16x4 l0 = *(const s16x4*)(Vc + r32 * RS + kofs), h0 = *(const s16x4*)(Vc + r32 * RS + kofs + 8);
            const s16x4 l1 = *(const s16x4*)(Vc + (32 + r32) * RS + kofs), h1 = *(const s16x4*)(Vc + (32 + r32) * RS + kofs + 8);
            const bf16x8 B0 = __builtin_shufflevector(l0, h0, 0, 1, 2, 3, 4, 5, 6, 7), B1 = __builtin_shufflevector(l1, h1, 0, 1, 2, 3, 4, 5, 6, 7);
            o0 = MFMA32(A, B0, o0); o1 = MFMA32(A, B1, o1);
        }
    }
    const int unit = (b * 4 + h) * 32 + n;
#pragma unroll 1
    for (int dir = 0; dir < 2; ++dir) {
        const bf16_t* Rt = RT + ((size_t)unit * 2 + dir) * 4096;
        const float wq = dir == 0 ? __builtin_amdgcn_exp2f(lgf2 * (float)(cq + 1)) : __builtin_amdgcn_exp2f(lgb2 * (float)(128 - cq));
#pragma unroll
        for (int s = 0; s < 4; ++s) {
            u32x4 w;
#pragma unroll
            for (int j = 0; j < 4; ++j) w[j] = pk2(bf2f((unsigned short)qr[s][2 * j]) * wq, bf2f((unsigned short)qr[s][2 * j + 1]) * wq);
            const bf16x8 A = __builtin_bit_cast(bf16x8, w);
            const bf16x8 b0 = *(const bf16x8*)(Rt + r32 * 64 + 16 * s + 8 * hi), b1 = *(const bf16x8*)(Rt + (32 + r32) * 64 + 16 * s + 8 * hi);
            o0 = MFMA32(A, b0, o0); o1 = MFMA32(A, b1, o1);
        }
    }
    const float g0 = gn[h * 64 + r32], g1 = gn[h * 64 + 32 + r32];
    int c0f = c0; LAUNDER_V(c0f);
#pragma unroll
    for (int r = 0; r < 16; ++r) {
        const float mean = half_sum(o0[r] + o1[r]) * (1.0f / 64.0f);
        const float d0 = o0[r] - mean, d1 = o1[r] - mean;
        const float var = half_sum(d0 * d0 + d1 * d1) * (1.0f / 64.0f);
        const float rstd = 1.0f / sqrtf(var + 1e-5f);
        const size_t t = tc + c0f + crow(r, hi);
        const float ga = bf2f(ZR[t * 1024 + 768 + h * 64 + r32]), gb = bf2f(ZR[t * 1024 + 768 + h * 64 + 32 + r32]);
        const float sa = ga / (1.0f + __expf(-ga)), sb = gb / (1.0f + __expf(-gb));
        MIX[t * 1024 + 768 + h * 64 + r32] = (bf16_t)(pk2(sa * d0 * rstd * g0, 0.f) & 0xffffu);
        MIX[t * 1024 + 768 + h * 64 + 32 + r32] = (bf16_t)(pk2(sb * d1 * rstd * g1, 0.f) & 0xffffu);
    }
    __syncthreads();
}

#define LAS __attribute__((address_space(3)))
#define XB_TMO      128
#define XB_XCNT(j)  (256  + 64 * (j))
#define XB_XSUB(j)  (1280 + 64 * (j))
#define XB_XGEN(j)  (2304 + 64 * (j))
#define XB_TOP      3328
#define XB_TOPGEN   3392
#define XCD_BAR_WORDS 3456
#define XB_SPIN_CAP (1u << 18)

__device__ __forceinline__ unsigned xb_ld(unsigned* p)              { return __hip_atomic_load(p, __ATOMIC_RELAXED, __HIP_MEMORY_SCOPE_AGENT); }
__device__ __forceinline__ unsigned xb_add(unsigned* p, unsigned v) { return __hip_atomic_fetch_add(p, v, __ATOMIC_RELAXED, __HIP_MEMORY_SCOPE_AGENT); }
__device__ __forceinline__ unsigned xb_xcc_id() { return (unsigned)__builtin_amdgcn_s_getreg((3 << 11) | 20) & 0xFu; }
#define XB_SPIN(cond, bar) do { unsigned _sp = 0; while (cond) { __builtin_amdgcn_s_sleep(1); \
    if ((++_sp & 255u) == 0u) { if (xb_ld(&(bar)[XB_TMO])) break; if (_sp > XB_SPIN_CAP) { atomicAdd(&(bar)[XB_TMO], 1u); break; } } } } while (0)

struct XcdBarrier {
    unsigned* bar; unsigned x; int tid;
    volatile LAS unsigned* st;
};

__device__ __forceinline__ XcdBarrier xcd_barrier_post(unsigned* bar, volatile LAS unsigned* st) {
    XcdBarrier b; b.bar = bar; b.x = xb_xcc_id(); b.st = st;
    if (threadIdx.x == 0) (void)xb_add(&bar[XB_XCNT(b.x)], 1u);
    return b;
}
__device__ __forceinline__ void xcd_barrier_complete(unsigned* bar, unsigned x, unsigned& nloc, unsigned& nx) {
    const unsigned G = gridDim.x * gridDim.y * gridDim.z;
    unsigned sum, cnt, mine, sp = 0u;
    for (;;) {
        sum = 0u; cnt = 0u; mine = 0u;
#pragma unroll
        for (unsigned j = 0; j < 16; ++j) { const unsigned c = xb_ld(&bar[XB_XCNT(j)]); sum += c; cnt += (c > 0u) ? 1u : 0u; mine = (j == x) ? c : mine; }
        if (sum == G) break;
        __builtin_amdgcn_s_sleep(1);
        if ((++sp & 255u) == 0u) { if (xb_ld(&bar[XB_TMO])) break; if (sp > XB_SPIN_CAP) { atomicAdd(&bar[XB_TMO], 1u); break; } }
    }
    nloc = mine > 0u ? mine : 1u; nx = cnt > 0u ? cnt : 1u;
}

__device__ __forceinline__ void xcd_barrier(const XcdBarrier& b) {
    asm volatile("s_waitcnt vmcnt(0)" ::: "memory");
    __syncthreads();
    if (b.tid == 0) {
        unsigned* bar = b.bar;
        __builtin_amdgcn_s_waitcnt(0);
        unsigned nloc = b.st[0], nx = b.st[1];
        if (nloc == 0u) { xcd_barrier_complete(bar, b.x, nloc, nx); b.st[0] = nloc; b.st[1] = nx; }
        const unsigned old = xb_add(&bar[XB_XSUB(b.x)], 1u);
        const unsigned gen = old / nloc;
        if (old + 1u == (gen + 1u) * nloc) {
            __builtin_amdgcn_fence(__ATOMIC_RELEASE, "agent");
            asm volatile("s_waitcnt vmcnt(0)" ::: "memory");
            const unsigned og = xb_add(&bar[XB_TOP], 1u);
            const unsigned tg = og / nx;
            if (og + 1u == (tg + 1u) * nx) xb_add(&bar[XB_TOPGEN], 1u);
            else XB_SPIN(xb_ld(&bar[XB_TOPGEN]) == tg, bar);
            __builtin_amdgcn_fence(__ATOMIC_ACQUIRE, "agent");
            xb_add(&bar[XB_XGEN(b.x)], 1u);
            asm volatile("s_waitcnt vmcnt(0)" ::: "memory");
        } else {
            XB_SPIN(xb_ld(&bar[XB_XGEN(b.x)]) == gen, bar);
            __builtin_amdgcn_fence(__ATOMIC_ACQUIRE, "agent");
            asm volatile("s_waitcnt vmcnt(0)" ::: "memory");
        }
    }
    __syncthreads();
}

constexpr size_t WS_BAR = 819200;
__global__ void __launch_bounds__(512, 2) fwd_megakernel(Params Pdummy) {
    extern __shared__ __attribute__((aligned(16))) unsigned char lds[];
    cg::grid_group grid = cg::this_grid();
    const int G = gridDim.x, bid = blockIdx.x;
    const int wave_s = __builtin_amdgcn_readfirstlane((int)threadIdx.x >> 6);
#define HWTID() (wave_s * 64 + (int)__builtin_amdgcn_mbcnt_hi(~0u, __builtin_amdgcn_mbcnt_lo(~0u, 0u)))
    const Params& P = Pdummy;
    PG8_LAS unsigned char* ldsl = (PG8_LAS unsigned char*)lds;
    unsigned* barw = (unsigned*)(kws() + WS_BAR);
    volatile LAS unsigned* MISCp = (volatile LAS unsigned*)(ldsl + 131072 + 512);
    { int tid = threadIdx.x; LAUNDER_V(tid);
      if (bid == 0) for (int i = tid; i < XCD_BAR_WORDS; i += 512) __hip_atomic_store(barw + i, 0u, __ATOMIC_RELAXED, __HIP_MEMORY_SCOPE_AGENT);
      if (bid == 0 && tid < 64) __hip_atomic_store((unsigned*)(kws() + WS_CTR) + tid * 64, 0u, __ATOMIC_RELAXED, __HIP_MEMORY_SCOPE_AGENT);
      if (tid < 2) MISCp[tid] = 0u;
      __threadfence();
      __syncthreads();
#ifndef SKIP_MOD
      phase_mod(P, lds, tid);
#endif
    }
    grid.sync();
    (void)xcd_barrier_post(barw, MISCp);
    for (int step = 0; step < L * 14; ++step) {
        const int l = step / 14, k = step % 14;
        if (k == 7) continue;
#ifndef REPMASK
#define REPMASK 0
#endif
#ifndef SUBMASK
#define SUBMASK 0
#endif
        const int nrep = ((REPMASK >> k) & 1) ? 2 : 1;
        for (int rep = 0; rep < nrep; ++rep) {
        int tid = HWTID(); LAUNDER_V(tid);
        const int lane = tid & 63, wave = tid >> 6;
        const int vcu = (G % 8 == 0) ? (bid % 8) * (G / 8) + bid / 8 : bid;
        const int gw = vcu * 8 + wave, NGW = G * 8;
        unsigned char* ws = kws();
        const float* modl = (const float*)(ws + WS_MOD) + (size_t)l * 4 * 9216;
        pg8::Gemm g{nullptr, nullptr, 0, 0, 0}; pg8::EpiX E{0, nullptr, nullptr, nullptr, 0.f, 0}; bool do_gemm = false;
        switch (k) {
        case 0:
#ifndef SKIP_CONV
            convert_weights(P, l, lds, gw, NGW, wave, lane);
#endif
            norm_rows(P, l == 0 ? (const float*)kin(0) : kout(), l == 0 ? kout() : nullptr, l, 0, gw, NGW, lane);
            break;
        case 1:
            g = pg8::Gemm{(const bf16_t*)(ws + WS_H), (const bf16_t*)(ws + WS_WBF + WB_W1A), T, 5632, 1024}; E = pg8::EpiX{0, nullptr, (bf16_t*)(ws + WS_A), nullptr, 0.f, FF}; do_gemm = true; break;
        case 2:
            g = pg8::Gemm{(const bf16_t*)(ws + WS_A), (const bf16_t*)(ws + WS_WBF + WB_W2A), T, 1024, FF}; E = pg8::EpiX{1, kout(), nullptr, modl + 2 * 1024, 0.5f, 0}; do_gemm = true; break;
        case 3:
            norm_rows(P, kout(), nullptr, l, 3, gw, NGW, lane); break;
        case 4:
            g = pg8::Gemm{(const bf16_t*)(ws + WS_H), (const bf16_t*)(ws + WS_WBF + WB_WIN), T, 3072, 1024}; E = pg8::EpiX{2, (float*)(ws + WS_ZF), (bf16_t*)(ws + WS_ZR), nullptr, 0.f, 0}; do_gemm = true; break;
        case 5:
#ifndef SKIP_RPREP
            rwkv_prep(P, l, lds, tid);
#endif
#ifndef SKIP_MPREP
            mla_prep(P, l, gw, NGW, lane);
#endif
            __syncthreads();
#ifndef SKIP_RSTATE
            if (rep == 0) ret_state(P, l, lds, tid);
#endif
            break;
        case 6:
#ifndef SKIP_RSCAN
            ret_scan(P, l, tid);
#endif
            g = pg8::Gemm{(const bf16_t*)(ws + WS_CQN), (const bf16_t*)(ws + WS_WBF + WB_WUQ), T, 768, 384}; E = pg8::EpiX{3, nullptr, (bf16_t*)(ws + WS_QB), nullptr, 0.f, 768}; do_gemm = true; break;
        case 7:
            break;
        case 8:
#ifndef SKIP_SCAN
            for (int sr = 0; sr < ((SUBMASK & 1) ? 2 : 1); ++sr) {
            const int sbx = (((bid & 7) + 8 * ((bid >> 3) >> 2)) << 2) | ((bid >> 3) & 3);
            if (bid < 128) { if (bid >= 64) rwkv_scan_dir<1>(P, lds, sbx, tid); else rwkv_scan_dir<0>(P, lds, sbx, tid); }
            __syncthreads();
            }
#endif
            {
                unsigned* ctrl = (unsigned*)(kws() + WS_CTR) + l * 16 * 64;
                volatile unsigned* slot = (volatile unsigned*)(lds + 131072 + 1024);
                const int x0 = (int)(xb_xcc_id() & 7u);
                volatile unsigned* avail = slot + 4;
                for (;;) {
                    __syncthreads();
                    if (tid < 9) avail[tid] = __hip_atomic_load(ctrl + tid * 64, __ATOMIC_RELAXED, __HIP_MEMORY_SCOPE_AGENT);
                    __syncthreads();
                    int xs = 0;
                    for (; xs < 9; ++xs) { const int q_ = xs < 8 ? ((x0 + xs) & 7) : 8; if (avail[q_] < (xs < 8 ? 64u : 256u)) break; }
                    if (xs == 9) break;
                    const int qx = xs < 8 ? ((x0 + xs) & 7) : 8;
                    const unsigned qn = xs < 8 ? 64u : 256u;
                    for (;;) {
                        __syncthreads();
                        if (tid == 0) *slot = atomicAdd(ctrl + qx * 64, 1u);
                        __syncthreads();
                        const unsigned u = *slot;
                        if (u >= qn) break;
                        int tq = tid; LAUNDER_V(tq);
                        if (xs < 8) { const int bh = qx * 4 + (int)(u >> 4); attn_unit(P, lds, bh >> 3, bh & 7, (int)(u & 15), tq); }
                        else ret_out(P, l, lds, (int)u, tq);
                    }
                }
            }
            break;
        case 9:
#ifndef SKIP_RPOST
            rwkv_post(P, l, gw, NGW, lane);
#endif
            break;
        case 10:
            g = pg8::Gemm{(const bf16_t*)(ws + WS_H), (const bf16_t*)(ws + WS_WBF + WB_WOUT), T, 1024, 1024}; E = pg8::EpiX{1, kout(), nullptr, modl + 5 * 1024, 1.0f, 0}; do_gemm = true; break;
        case 11:
            norm_rows(P, kout(), nullptr, l, 6, gw, NGW, lane); break;
        case 12:
            g = pg8::Gemm{(const bf16_t*)(ws + WS_H), (const bf16_t*)(ws + WS_WBF + WB_W1B), T, 5632, 1024}; E = pg8::EpiX{0, nullptr, (bf16_t*)(ws + WS_A), nullptr, 0.f, FF}; do_gemm = true; break;
        default:
            g = pg8::Gemm{(const bf16_t*)(ws + WS_A), (const bf16_t*)(ws + WS_WBF + WB_W2B), T, 1024, FF}; E = pg8::EpiX{1, kout(), nullptr, modl + 8 * 1024, 0.5f, 0}; do_gemm = true; break;
        }
        if (rep > 0 && E.MODE == 1) E.coef = 0.f;
        if (do_gemm) {
            const int ngemm = (k == 6) ? 2 : 1;
            for (int gi = 0; gi < ngemm; ++gi) {
                int tg = tid; LAUNDER_V(tg);
                if (gi == 1) { g = pg8::Gemm{(const bf16_t*)(ws + WS_CKVN), (const bf16_t*)(ws + WS_WBF + WB_WUKV), T, 1024, 256}; E = pg8::EpiX{4, (float*)(ws + WS_VT), (bf16_t*)(ws + WS_KVB), nullptr, 0.f, 1024}; }
                pg8::StaticOrder So; So.init(g.M, g.N, G, bid); pg8::gemm_phase<pg8::EpiX, pg8::StaticOrder, true, true>(ldsl, g, So, E, tg);
            }
        }
        { XcdBarrier xb; xb.bar = (unsigned*)(kws() + WS_BAR); xb.x = xb_xcc_id(); xb.tid = tid; xb.st = (volatile LAS unsigned*)(ldsl + 131072 + 512); xcd_barrier(xb); }
        }
    }
    { int tid = HWTID(); LAUNDER_V(tid);
      const int lane = tid & 63, wave = tid >> 6;
      const int vcu = (G % 8 == 0) ? (bid % 8) * (G / 8) + bid / 8 : bid;
      final_norm(P, vcu * 8 + wave, G * 8, lane); }
}
}

extern "C" void kernel_launch(void* const* d_in, const int* in_sizes, int n_in, void* d_out, int out_size, void* d_ws, size_t ws_size, hipStream_t stream) {
    static int grid = 0;
    if (grid == 0) {
        if (n_in != 29 || out_size != mk::T * mk::D || ws_size < mk::WS_END) { fprintf(stderr, "kernel_launch: unexpected shapes (n_in %d, out %d, ws %zu)\n", n_in, out_size, ws_size); grid = -1; return; }
        int dev = 0, cus = 0, per_cu = 0;
        hipGetDevice(&dev);
        hipDeviceGetAttribute(&cus, hipDeviceAttributeMultiprocessorCount, dev);
        hipFuncSetAttribute((const void*)mk::fwd_megakernel, hipFuncAttributeMaxDynamicSharedMemorySize, mk::LDS_BYTES);
        hipOccupancyMaxActiveBlocksPerMultiprocessor(&per_cu, (const void*)mk::fwd_megakernel, 512, mk::LDS_BYTES);
        if (per_cu < 1) per_cu = 1;
        grid = cus * per_cu;
        (void)hipGetLastError();
    }
    if (grid < 0) return;
    mk::Params p{};
    for (int i = 0; i < 29; ++i) p.in[i] = d_in[i];
    p.out = (float*)d_out; p.ws = (unsigned char*)d_ws;
    void* args[] = {&p};
    hipError_t e = hipLaunchCooperativeKernel((const void*)mk::fwd_megakernel, dim3(grid), dim3(512), args, mk::LDS_BYTES, stream);
    if (e != hipSuccess) fprintf(stderr, "cooperative launch failed: %s (grid %d)\n", hipGetErrorString(e), grid);
}
```

```cpp
#include <hip/hip_runtime.h>
#include <hip/hip_cooperative_groups.h>
#include <cstdio>
#include <cstdint>
#include <cmath>
namespace cg = cooperative_groups;
namespace pg8 {
#define PG8_LAS __attribute__((address_space(3)))
typedef unsigned short bf16_t;
typedef short bf16x8 __attribute__((ext_vector_type(8)));
typedef float f32x4 __attribute__((ext_vector_type(4)));
typedef unsigned u32x4 __attribute__((ext_vector_type(4)));
constexpr int BM = 256, BK = 64, HALF = 128, HTB = HALF * BK * 2  , STAGE_BYTES = 8 * HTB, NXCD = 8, WGM = 8;

__host__ __device__ __forceinline__ int lds_byte(int r, int c) { const int st = (r >> 4) * 2 + (c >> 5), rr = r & 15, cc = c & 31, ob = rr * 64 + cc * 2; return st * 1024 + (ob ^ (((ob >> 9) & 1) << 5)); }
__host__ __device__ __forceinline__ void stage_rc(int b, int& R, int& C) { const int st = b / 1024, sb = b % 1024, swz = sb ^ (((sb >> 9) & 1) << 5); R = (st >> 1) * 16 + swz / 64; C = (st & 1) * 32 + (swz % 64) / 2; }
__host__ __device__ __forceinline__ int perm32(int rho) { const int n = rho >> 4, i = rho & 15; return 8 * (i >> 2) + 4 * n + (i & 3); }

struct Unit { int pm, pn; };
struct Gemm { const bf16_t* A; const bf16_t* Bt; int M, N, K; };

struct StaticOrder {
    int nM, nN, nwg, G, c;
    __host__ __device__ void init(int M, int N, int G_, int c_) { nM = M / BM; nN = N / BM; nwg = nM * nN; G = G_; c = c_; }
    __host__ __device__ bool next(int i, Unit& u) const {
        const long L = (long)i * G + c; if (L >= nwg) return false;
        int wgid = (int)L; { const int q = nwg / NXCD, r = nwg % NXCD, xcd = wgid % NXCD, off = wgid / NXCD; wgid = (xcd < r ? xcd * (q + 1) : r * (q + 1) + (xcd - r) * q) + off; }
        const int nig = WGM * nN, gid = wgid / nig, fm = gid * WGM, gsz = (nM - fm) < WGM ? (nM - fm) : WGM;
        u.pm = fm + ((wgid % nig) % gsz); u.pn = (wgid % nig) / gsz; return true;
    }
    __device__ __forceinline__ void a_ready(const Unit&) const {}
    __device__ __forceinline__ void done(const Unit&) const {}
};

__device__ __forceinline__ unsigned cvt_pk_bf16(float lo, float hi) { unsigned r; asm volatile("v_cvt_pk_bf16_f32 %0, %1, %2" : "=v"(r) : "v"(lo), "v"(hi)); return r; }
typedef float f32x2 __attribute__((ext_vector_type(2)));
typedef unsigned u32x2e __attribute__((ext_vector_type(2)));
typedef __bf16 bf16x2e __attribute__((ext_vector_type(2)));
__device__ __forceinline__ unsigned pk_bf16_rne(float lo, float hi) { f32x2 v = {lo, hi}; bf16x2e b = __builtin_convertvector(v, bf16x2e); return __builtin_bit_cast(unsigned, b); }
__device__ __forceinline__ float silu_f(float x) { return x * __builtin_amdgcn_rcpf(1.0f + __expf(-x)); }
struct EpiX {
    int MODE;
    static constexpr bool PERM = false, AFTER_DRAIN = false;
    float* F; bf16_t* Hh; const float* gv; float coef; int ldo;
    __device__ __forceinline__ void operator()(const f32x4 (&acc)[2][2][4][2], const Unit& u, int wr, int wc, int fr, int fq) const {
#pragma unroll
        for (int ai = 0; ai < 2; ++ai)
#pragma unroll
            for (int m = 0; m < 4; ++m) {
                const int r = u.pm * BM + ai * HALF + wr * 64 + m * 16 + fr;
#pragma unroll
                for (int bj = 0; bj < 2; ++bj) {
                    const int cb = u.pn * BM + bj * HALF + wc * 32;
                    const f32x4 v0 = acc[ai][bj][m][0], v1 = acc[ai][bj][m][1];
                    if (MODE == 0) {
                        u32x2e w; w.x = pk_bf16_rne(silu_f(v0[0]) * v1[0], silu_f(v0[1]) * v1[1]); w.y = pk_bf16_rne(silu_f(v0[2]) * v1[2], silu_f(v0[3]) * v1[3]);
                        *(u32x2e*)(Hh + (size_t)r * ldo + (cb >> 1) + 4 * fq) = w;
                    } else if (MODE == 1) {
                        const int b = r >> 12;
#pragma unroll
                        for (int n = 0; n < 2; ++n) { const int c = cb + 16 * n + 4 * fq; const f32x4 g = *(const f32x4*)(gv + b * 9216 + c); f32x4* xp = (f32x4*)(F + (size_t)r * 1024 + c);
                            f32x4 x = *xp; x += (n == 0 ? v0 : v1) * g * coef; *xp = x; }
                    } else if (MODE == 2) {
                        if (u.pn < 8) {
                            *(f32x4*)(F + (size_t)r * 2048 + cb + 4 * fq) = v0; *(f32x4*)(F + (size_t)r * 2048 + cb + 16 + 4 * fq) = v1;
                        } else {
                            u32x2e w0, w1; w0.x = pk_bf16_rne(v0[0], v0[1]); w0.y = pk_bf16_rne(v0[2], v0[3]); w1.x = pk_bf16_rne(v1[0], v1[1]); w1.y = pk_bf16_rne(v1[2], v1[3]);
                            *(u32x2e*)(Hh + (size_t)r * 1024 + (cb - 2048) + 4 * fq) = w0; *(u32x2e*)(Hh + (size_t)r * 1024 + (cb - 2048) + 16 + 4 * fq) = w1;
                        }
                    } else if (MODE == 4 && wc >= 2) {
                        const int hh = u.pn * 2 + bj, e0 = (wc - 2) * 32 + 4 * fq, bb = r >> 12, ss = r & 4095;
                        const int ssp = (ss & ~12) | ((ss & 4) << 1) | ((ss & 8) >> 1);
                        bf16_t* vt = (bf16_t*)F + ((size_t)((bb * 8 + hh) * 64 + e0)) * 4096 + ssp;
#pragma unroll
                        for (int j = 0; j < 4; ++j) { vt[(size_t)j * 4096] = (bf16_t)(pk_bf16_rne(v0[j], 0.f) & 0xffffu); vt[(size_t)(16 + j) * 4096] = (bf16_t)(pk_bf16_rne(v1[j], 0.f) & 0xffffu); }
                    } else {
                        u32x2e w0, w1; w0.x = pk_bf16_rne(v0[0], v0[1]); w0.y = pk_bf16_rne(v0[2], v0[3]); w1.x = pk_bf16_rne(v1[0], v1[1]); w1.y = pk_bf16_rne(v1[2], v1[3]);
                        *(u32x2e*)(Hh + (size_t)r * ldo + cb + 4 * fq) = w0; *(u32x2e*)(Hh + (size_t)r * ldo + cb + 16 + 4 * fq) = w1;
                    }
                }
            }
    }
};
template <class Epi, class Sched, bool ALIGN_EPI = false, bool SP2 = false>
__device__ __forceinline__ void gemm_phase(PG8_LAS unsigned char* lds, const Gemm g, const Sched& S, const Epi& E, int tid_in) {
    int tid_l = tid_in; asm volatile("" : "+v"(tid_l));
    const int tid = tid_l, wid = __builtin_amdgcn_readfirstlane(tid >> 6), lane = tid & 63, wr = wid >> 2, wc = wid & 3, fr = lane & 15, fq = lane >> 4;
    const int K = g.K, nt = K / BK;
    unsigned voffA[2], voffB[2];
#pragma unroll
    for (int i = 0; i < 2; ++i) { int R, C; stage_rc(tid * 16 + i * 8192, R, C); const int Rb = Epi::PERM ? ((R & ~31) + perm32(R & 31)) : R;
        voffA[i] = (unsigned)(R * K + C) * 2u; voffB[i] = (unsigned)(Rb * K + C) * 2u; }
    const size_t kstep = (size_t)(BK * 2);
    const size_t hstep = (size_t)HALF * K * 2;
    const size_t tstep = 2 * hstep;
    const unsigned ldsw = (unsigned)wid * 1024u;
    const int aoff = lds_byte(wr * 64 + fr, fq * 8), boff = lds_byte(wc * 32 + fr, fq * 8);
#define PG8_SA(b, h) (((b) * 2 + (h)) * HTB)
#define PG8_SB(b, h) ((4 + (b) * 2 + (h)) * HTB)
#define PG8_STAGE(bufoff, gbase, voff) do { _Pragma("unroll") for (int _i = 0; _i < 2; ++_i) \
        __builtin_amdgcn_global_load_lds((const unsigned*)((const char*)(gbase) + (voff)[_i]), (PG8_LAS unsigned*)(lds + (bufoff) + ldsw + _i * 8192), 16, 0, 0); } while (0)
#define PG8_LDA(dst, b, h) do { _Pragma("unroll") for (int m = 0; m < 4; ++m) _Pragma("unroll") for (int k = 0; k < 2; ++k) dst[m][k] = *(const PG8_LAS bf16x8*)(lds + PG8_SA(b, h) + aoff + m * 2048 + k * 1024); } while (0)
#define PG8_LDB(dst, b, h) do { _Pragma("unroll") for (int n = 0; n < 2; ++n) _Pragma("unroll") for (int k = 0; k < 2; ++k) dst[n][k] = *(const PG8_LAS bf16x8*)(lds + PG8_SB(b, h) + boff + n * 2048 + k * 1024); } while (0)
#define PG8_MMA(ai, bj, At, Bt) do { __builtin_amdgcn_s_setprio(1); _Pragma("unroll") for (int m = 0; m < 4; ++m) _Pragma("unroll") for (int n = 0; n < 2; ++n) _Pragma("unroll") for (int k = 0; k < 2; ++k) \
        acc[ai][bj][m][n] = __builtin_amdgcn_mfma_f32_16x16x32_bf16(Bt[n][k], At[m][k], acc[ai][bj][m][n], 0, 0, 0); __builtin_amdgcn_s_setprio(0); } while (0)
#define PG8_WAIT_V(n) asm volatile("s_waitcnt vmcnt(" #n ")" ::: "memory")
#define PG8_WAIT_L(n) asm volatile("s_waitcnt lgkmcnt(" #n ")" ::: "memory")
#define PG8_BAR __builtin_amdgcn_s_barrier()
#define PG8_SCHED __builtin_amdgcn_sched_barrier(0)
    Unit cur, nxt; int ui = 0;
    if (!S.next(0, cur)) return;
    f32x4 acc[2][2][4][2];
#pragma unroll
    for (int a = 0; a < 2; ++a)
#pragma unroll
        for (int b = 0; b < 2; ++b)
#pragma unroll
            for (int m = 0; m < 4; ++m)
#pragma unroll
                for (int n = 0; n < 2; ++n) acc[a][b][m][n] = (f32x4){0.f, 0.f, 0.f, 0.f};
    bf16x8 At[4][2], B0[2][2], B1[2][2];
    const char* cA = (const char*)g.A + (size_t)cur.pm * tstep; const char* cB = (const char*)g.Bt + (size_t)cur.pn * tstep;
    S.a_ready(cur);
    if constexpr (SP2) {
        PG8_STAGE(PG8_SB(0, 0), cB, voffB); PG8_STAGE(PG8_SB(0, 1), cB + hstep, voffB); PG8_STAGE(PG8_SA(0, 0), cA, voffA); PG8_STAGE(PG8_SA(0, 1), cA + hstep, voffA);
        if (wr == 1) PG8_BAR;
        PG8_WAIT_V(2); PG8_BAR;
        PG8_STAGE(PG8_SB(1, 0), cB + kstep, voffB); PG8_STAGE(PG8_SA(1, 0), cA + kstep, voffA); PG8_STAGE(PG8_SB(1, 1), cB + hstep + kstep, voffB);
        PG8_WAIT_V(6); PG8_BAR;
    } else {
        PG8_STAGE(PG8_SB(0, 0), cB, voffB); PG8_STAGE(PG8_SA(0, 0), cA, voffA); PG8_STAGE(PG8_SB(0, 1), cB + hstep, voffB); PG8_STAGE(PG8_SA(0, 1), cA + hstep, voffA);
        if (wr == 1) PG8_BAR;
        PG8_WAIT_V(4); PG8_BAR;
        PG8_STAGE(PG8_SB(1, 0), cB + kstep, voffB); PG8_STAGE(PG8_SA(1, 0), cA + kstep, voffA); PG8_STAGE(PG8_SB(1, 1), cB + hstep + kstep, voffB);
        PG8_WAIT_V(6); PG8_BAR;
    }
    for (;;) {
        const bool has_next = S.next(ui + 1, nxt);
        const char* nA = has_next ? (const char*)g.A + (size_t)nxt.pm * tstep : cA; const char* nB = has_next ? (const char*)g.Bt + (size_t)nxt.pn * tstep : cB;
        for (int t = 0; t < nt; t += 2) {
            const bool last = (t == nt - 2);
            const char* a1 = cA + (size_t)(t + 1) * kstep;
            const char* a2 = last ? nA : cA + (size_t)(t + 2) * kstep; const char* b2 = last ? nB : cB + (size_t)(t + 2) * kstep;
            const char* a3 = a2 + kstep; const char* b3 = b2 + kstep;
            if (last && has_next) S.a_ready(nxt);
            if constexpr (SP2) {
            PG8_LDB(B0, 0, 0); PG8_LDB(B1, 0, 1); PG8_SCHED; PG8_LDA(At, 0, 0); PG8_STAGE(PG8_SA(1, 1), a1 + hstep, voffA);
            PG8_WAIT_V(8); PG8_WAIT_L(0); PG8_BAR; PG8_MMA(0, 0, At, B0); PG8_MMA(0, 1, At, B1); PG8_BAR; PG8_SCHED;
            PG8_LDA(At, 0, 1); PG8_STAGE(PG8_SB(0, 0), b2, voffB); PG8_STAGE(PG8_SB(0, 1), b2 + hstep, voffB); PG8_STAGE(PG8_SA(0, 0), a2, voffA);
            PG8_WAIT_V(8); PG8_WAIT_L(0); PG8_BAR; PG8_MMA(1, 0, At, B0); PG8_MMA(1, 1, At, B1); PG8_BAR; PG8_SCHED;
            PG8_LDB(B0, 1, 0); PG8_LDB(B1, 1, 1); PG8_SCHED; PG8_LDA(At, 1, 0); PG8_STAGE(PG8_SA(0, 1), a2 + hstep, voffA);
            PG8_WAIT_V(8); PG8_WAIT_L(0); PG8_BAR; PG8_MMA(0, 0, At, B0); PG8_MMA(0, 1, At, B1); PG8_BAR; PG8_SCHED;
            PG8_LDA(At, 1, 1); PG8_STAGE(PG8_SB(1, 0), b3, voffB); PG8_STAGE(PG8_SB(1, 1), b3 + hstep, voffB); PG8_STAGE(PG8_SA(1, 0), a3, voffA);
            PG8_WAIT_V(8); PG8_WAIT_L(0); PG8_BAR; PG8_MMA(1, 0, At, B0); PG8_MMA(1, 1, At, B1); PG8_BAR; PG8_SCHED;
            } else {
            PG8_LDB(B0, 0, 0); PG8_SCHED; PG8_LDA(At, 0, 0); PG8_STAGE(PG8_SA(1, 1), a1 + hstep, voffA);
            PG8_WAIT_L(8); PG8_BAR; PG8_WAIT_L(0); PG8_MMA(0, 0, At, B0); PG8_BAR; PG8_SCHED;
            PG8_LDB(B1, 0, 1); PG8_STAGE(PG8_SB(0, 0), b2, voffB);
            PG8_BAR; PG8_WAIT_L(0); PG8_MMA(0, 1, At, B1); PG8_BAR;
            PG8_LDA(At, 0, 1); PG8_STAGE(PG8_SA(0, 0), a2, voffA);
            PG8_BAR; PG8_WAIT_L(0); PG8_MMA(1, 0, At, B0); PG8_BAR; PG8_SCHED;
            PG8_STAGE(PG8_SB(0, 1), b2 + hstep, voffB);
            PG8_WAIT_V(6); PG8_BAR; PG8_MMA(1, 1, At, B1); PG8_BAR;
            PG8_LDB(B0, 1, 0); PG8_SCHED; PG8_LDA(At, 1, 0); PG8_STAGE(PG8_SA(0, 1), a2 + hstep, voffA);
            PG8_WAIT_L(8); PG8_BAR; PG8_WAIT_L(0); PG8_MMA(0, 0, At, B0); PG8_BAR; PG8_SCHED;
            PG8_LDB(B1, 1, 1); PG8_STAGE(PG8_SB(1, 0), b3, voffB);
            PG8_BAR; PG8_WAIT_L(0); PG8_MMA(0, 1, At, B1); PG8_BAR;
            PG8_LDA(At, 1, 1); PG8_STAGE(PG8_SA(1, 0), a3, voffA);
            PG8_BAR; PG8_WAIT_L(0); PG8_MMA(1, 0, At, B0); PG8_BAR; PG8_SCHED;
            PG8_STAGE(PG8_SB(1, 1), b3 + hstep, voffB);
            PG8_WAIT_V(6); PG8_BAR; PG8_MMA(1, 1, At, B1); PG8_BAR;
            }
        }
        if constexpr (ALIGN_EPI) { if (wr == 0) PG8_BAR; }
        if constexpr (!Epi::AFTER_DRAIN) { E(acc, cur, wr, wc, fr, fq); S.done(cur); }
        if (!has_next) break;
#pragma unroll
        for (int a = 0; a < 2; ++a)
#pragma unroll
            for (int b = 0; b < 2; ++b)
#pragma unroll
                for (int m = 0; m < 4; ++m)
#pragma unroll
                    for (int n = 0; n < 2; ++n) acc[a][b][m][n] = (f32x4){0.f, 0.f, 0.f, 0.f};
        cur = nxt; cA = nA; cB = nB; ++ui;
        if constexpr (ALIGN_EPI) { if (wr == 1) PG8_BAR; }
    }
    PG8_WAIT_V(0);
    if constexpr (!ALIGN_EPI) { if (wr == 0) PG8_BAR; }
    PG8_BAR;
    if constexpr (Epi::AFTER_DRAIN) { E.fused(acc, cur, wr, wc, fr, fq, lds, wid, lane); S.done(cur); }
#undef PG8_SA
#undef PG8_SB
#undef PG8_STAGE
#undef PG8_LDA
#undef PG8_LDB
#undef PG8_MMA
#undef PG8_WAIT_V
#undef PG8_WAIT_L
#undef PG8_BAR
#undef PG8_SCHED
}
}
namespace mk {
using pg8::bf16_t; using pg8::bf16x8; using pg8::f32x4;
typedef float f32x16 __attribute__((ext_vector_type(16)));
typedef float f32x2 __attribute__((ext_vector_type(2)));
typedef unsigned u32x4 __attribute__((ext_vector_type(4)));
typedef unsigned u32x2 __attribute__((ext_vector_type(2)));
typedef short s16x4 __attribute__((ext_vector_type(4)));

constexpr int NB = 4, S = 4096, T = NB * S, D = 1024, L = 4, FF = 2816;
constexpr size_t MiB = 1u << 20;
constexpr size_t WS_MOD = 0, WS_WBF = 1 * MiB, WS_H = 44 * MiB, WS_ZF = 76 * MiB, WS_A = 76 * MiB, WS_Y = 76 * MiB, WS_QB = 108 * MiB, WS_KVB = 132 * MiB, WS_RT = 164 * MiB,
    WS_ZR = 204 * MiB, WS_CQN = 236 * MiB, WS_CKVN = 248 * MiB, WS_KPE = 256 * MiB, WS_DEC = 257 * MiB, WS_KKA = 289 * MiB, WS_KMOD = 321 * MiB, WS_KK = 353 * MiB,
    WS_RKV = 369 * MiB, WS_G = 417 * MiB, WS_KVT = 433 * MiB, WS_END = 449 * MiB, WS_VT = 172 * MiB, WS_CTR = 819200 + 16384;
constexpr size_t WB_W1A = 0, WB_W2A = 11534336, WB_W1B = 17301504, WB_W2B = 28835840, WB_WIN = 34603008, WB_WOUT = 40894464, WB_WUQ = 42991616, WB_WUKV = 43581440, WB_LWUP = 44105728, WB_LAUP = 44105728 + 65536, WB_LGUP = 44105728 + 131072;
constexpr int LDS_BYTES = 147456;
constexpr float LOG2E = 1.4426950408889634f, LOG2_1E4 = 13.287712379549449f;

struct Params { const void* in[29]; float* out; unsigned char* ws; };
typedef __attribute__((address_space(4))) const unsigned long long* karg_ptr;
__device__ __forceinline__ const void* kin(int i) { karg_ptr ka = (karg_ptr)__builtin_amdgcn_kernarg_segment_ptr(); asm volatile("" : "+s"(ka)); return (const void*)(__attribute__((address_space(1))) const void*)ka[i]; }
__device__ __forceinline__ float* kout() { return (float*)kin(29); }
__device__ __forceinline__ unsigned char* kws() { return (unsigned char*)kin(30); }
#define LAUNDER_V(x) asm volatile("" : "+v"(x))

__device__ __forceinline__ unsigned pk2(float lo, float hi) { return pg8::pk_bf16_rne(lo, hi); }
__device__ __forceinline__ float bf2f(unsigned short u) { return __uint_as_float(((unsigned)u) << 16); }
template <int CTRL> __device__ __forceinline__ float dppr_add(float x) { const int y = __builtin_amdgcn_update_dpp(0, __float_as_int(x), CTRL, 0xf, 0xf, false); return x + __int_as_float(y); }
__device__ __forceinline__ float row16_allsum(float x) { x = dppr_add<0x128>(x); x = dppr_add<0x124>(x); x = dppr_add<0x122>(x); x = dppr_add<0x121>(x); return x; }
__device__ __forceinline__ float rows_pair_sum(float v) { auto r = __builtin_amdgcn_permlane16_swap(__float_as_uint(v), __float_as_uint(v), false, false); return __uint_as_float(r[0]) + __uint_as_float(r[1]); }
__device__ __forceinline__ float halves_pair_sum(float v) { auto r = __builtin_amdgcn_permlane32_swap(__float_as_uint(v), __float_as_uint(v), false, false); return __uint_as_float(r[0]) + __uint_as_float(r[1]); }
__device__ __forceinline__ float wave_sum(float v) { v = row16_allsum(v); v = rows_pair_sum(v); v = halves_pair_sum(v); return v; }
__device__ __forceinline__ float half_sum(float v) { v = row16_allsum(v); v = rows_pair_sum(v); return v; }
__device__ __forceinline__ int crow(int r, int hi) { return (r & 3) + 8 * (r >> 2) + 4 * hi; }
#define MFMA32(a, b, c) __builtin_amdgcn_mfma_f32_32x32x16_bf16((a), (b), (c), 0, 0, 0)
#define LDSWAIT() asm volatile("s_waitcnt lgkmcnt(0)" ::: "memory")
__device__ __forceinline__ void sincos_rr(float ang, float& s, float& c) {
    const float k = rintf(ang * 0.15915494309189535f);
    float r = fmaf(-k, 6.2831854820251465f, ang);
    r = fmaf(-k, -1.7484556e-7f, r);
    s = __sinf(r); c = __cosf(r);
}
__device__ __forceinline__ float sigmoid_f(float x) { return 1.0f / (1.0f + expf(-x)); }

__device__ __forceinline__ void phase_mod(const Params& P, unsigned char* lds, int tid) {
    float* cond = (float*)lds; float* red = cond + 4096;
    const float* c = (const float*)kin(1); const float* w_ada = (const float*)kin(3); const float* b_ada = (const float*)kin(4);
    float* mod = (float*)(kws() + WS_MOD);
    for (int i = tid; i < 4096; i += 512) { const float v = c[i]; cond[i] = v / (1.0f + expf(-v)); }
    __syncthreads();
    const int ks = tid >> 4, cq = tid & 15;
    for (int item = blockIdx.x; item < 576; item += gridDim.x) {
        const int l = item / 144, n0 = (item % 144) * 64;
        const float* W = w_ada + (size_t)l * 1024 * 9216 + (size_t)(ks * 32) * 9216 + n0 + 4 * cq;
        f32x4 a0 = {0.f, 0.f, 0.f, 0.f}, a1 = a0, a2 = a0, a3 = a0;
        f32x4 wv[32];
#pragma unroll
        for (int k = 0; k < 32; ++k) wv[k] = *(const f32x4*)(W + (size_t)k * 9216);
#pragma unroll
        for (int k = 0; k < 32; ++k) { const int kk = ks * 32 + k; a0 += wv[k] * cond[kk]; a1 += wv[k] * cond[1024 + kk]; a2 += wv[k] * cond[2048 + kk]; a3 += wv[k] * cond[3072 + kk]; }
        *(f32x4*)(red + (ks * 4 + 0) * 64 + 4 * cq) = a0; *(f32x4*)(red + (ks * 4 + 1) * 64 + 4 * cq) = a1; *(f32x4*)(red + (ks * 4 + 2) * 64 + 4 * cq) = a2; *(f32x4*)(red + (ks * 4 + 3) * 64 + 4 * cq) = a3;
        __syncthreads();
        if (tid < 256) { const int b = tid >> 6, col = tid & 63; float sum = 0.f;
#pragma unroll
            for (int q = 0; q < 32; ++q) sum += red[(q * 4 + b) * 64 + col];
            mod[(size_t)(l * 4 + b) * 9216 + n0 + col] = sum + b_ada[l * 9216 + n0 + col]; }
        __syncthreads();
    }
}

__device__ __forceinline__ int srccol(int kind, int rho) {
    if (kind == 1) { const int G = rho >> 5, w = rho & 31; return w < 16 ? 16 * G + w : 2816 + 16 * G + (w - 16); }
    if (kind == 2) { return rho < 1824 ? rho : (rho < 2048 ? -1 : rho - 224); }
    return rho;
}
__device__ __forceinline__ void tr_item(const float* W, int K, int Nsrc, int Ndst, bf16_t* WT, int kind, float* scr, int item, int lane) {
    const int nblk = Ndst / 32, kb = item / nblk, nb = item % nblk, k0 = 64 * kb, n0 = 32 * nb;
    const int sc = srccol(kind, n0 + (lane & 31));
    float tv[32];
#pragma unroll
    for (int i = 0; i < 32; ++i) { const int kk = 2 * i + (lane >> 5); tv[i] = sc >= 0 ? W[(size_t)(k0 + kk) * Nsrc + sc] : 0.f; }
#pragma unroll
    for (int i = 0; i < 32; ++i) { const int kk = 2 * i + (lane >> 5); scr[kk * 33 + (lane & 31)] = tv[i]; }
    LDSWAIT();
    const int c = lane & 7;
#pragma unroll
    for (int j = 0; j < 4; ++j) { const int n = (lane >> 3) + 8 * j; const float* s = scr + (8 * c) * 33 + n;
        u32x4 o; o.x = pk2(s[0 * 33], s[1 * 33]); o.y = pk2(s[2 * 33], s[3 * 33]); o.z = pk2(s[4 * 33], s[5 * 33]); o.w = pk2(s[6 * 33], s[7 * 33]);
        *(u32x4*)(WT + (size_t)(n0 + n) * K + k0 + 8 * c) = o; }
    LDSWAIT();
}
__device__ __forceinline__ void convert_weights(const Params& P, int l, unsigned char* lds, int gw, int NGW, int wave, int lane) {
    float* scr = (float*)(lds + wave * 16384);
    unsigned char* wb = kws() + WS_WBF;
    constexpr int I_W1 = 16 * 176, I_W2 = 44 * 32, I_IN = 16 * 96, I_OUT = 16 * 32, I_UQ = 6 * 24, I_UKV = 4 * 32;
    constexpr int I_LO = 8, I_LG = 16;
    constexpr int NIT = 2 * I_W1 + 2 * I_W2 + I_IN + I_OUT + I_UQ + I_UKV + 4 * I_LO + I_LG;
    for (int it = gw; it < NIT; it += NGW) {
        int r = it;
        if (r < I_W1) { tr_item((const float*)kin(5) + (size_t)l * 1024 * 5632, 1024, 5632, 5632, (bf16_t*)(wb + WB_W1A), 1, scr, r, lane); continue; } r -= I_W1;
        if (r < I_W2) { tr_item((const float*)kin(6) + (size_t)l * 2816 * 1024, 2816, 1024, 1024, (bf16_t*)(wb + WB_W2A), 0, scr, r, lane); continue; } r -= I_W2;
        if (r < I_W1) { tr_item((const float*)kin(7) + (size_t)l * 1024 * 5632, 1024, 5632, 5632, (bf16_t*)(wb + WB_W1B), 1, scr, r, lane); continue; } r -= I_W1;
        if (r < I_W2) { tr_item((const float*)kin(8) + (size_t)l * 2816 * 1024, 2816, 1024, 1024, (bf16_t*)(wb + WB_W2B), 0, scr, r, lane); continue; } r -= I_W2;
        if (r < I_IN) { tr_item((const float*)kin(9) + (size_t)l * 1024 * 2848, 1024, 2848, 3072, (bf16_t*)(wb + WB_WIN), 2, scr, r, lane); continue; } r -= I_IN;
        if (r < I_OUT) { tr_item((const float*)kin(10) + (size_t)l * 1024 * 1024, 1024, 1024, 1024, (bf16_t*)(wb + WB_WOUT), 0, scr, r, lane); continue; } r -= I_OUT;
        if (r < I_UQ) { tr_item((const float*)kin(23) + (size_t)l * 384 * 768, 384, 768, 768, (bf16_t*)(wb + WB_WUQ), 0, scr, r, lane); continue; } r -= I_UQ;
        if (r < I_UKV) { tr_item((const float*)kin(25) + (size_t)l * 256 * 1024, 256, 1024, 1024, (bf16_t*)(wb + WB_WUKV), 0, scr, r, lane); continue; } r -= I_UKV;
        if (r < 2 * I_LO) { const int d = r / I_LO; tr_item((const float*)kin(13) + (size_t)(l * 2 + d) * 64 * 256, 64, 256, 256, (bf16_t*)(wb + WB_LWUP) + d * 256 * 64, 0, scr, r % I_LO, lane); continue; } r -= 2 * I_LO;
        if (r < 2 * I_LO) { const int d = r / I_LO; tr_item((const float*)kin(15) + (size_t)(l * 2 + d) * 64 * 256, 64, 256, 256, (bf16_t*)(wb + WB_LAUP) + d * 256 * 64, 0, scr, r % I_LO, lane); continue; } r -= 2 * I_LO;
        tr_item((const float*)kin(16) + (size_t)l * 128 * 256, 128, 256, 256, (bf16_t*)(wb + WB_LGUP), 0, scr, r, lane);
    }
}

__device__ __forceinline__ void norm_rows(const Params& P, const float* src, float* copy_dst, int l, int shi, int gw, int NGW, int lane) {
    const float* modl = (const float*)(kws() + WS_MOD) + (size_t)l * 4 * 9216;
    bf16_t* H = (bf16_t*)(kws() + WS_H);
    for (int m0 = 2 * gw; m0 < T; m0 += 2 * NGW) {
        f32x4 v[2][4]; float s[2] = {0.f, 0.f};
#pragma unroll
        for (int q = 0; q < 2; ++q) { const f32x4* xr = (const f32x4*)(src + (size_t)(m0 + q) * D) + lane;
#pragma unroll
            for (int j = 0; j < 4; ++j) v[q][j] = xr[64 * j]; }
#pragma unroll
        for (int q = 0; q < 2; ++q) {
#pragma unroll
            for (int j = 0; j < 4; ++j) s[q] += (v[q][j].x * v[q][j].x + v[q][j].y * v[q][j].y) + (v[q][j].z * v[q][j].z + v[q][j].w * v[q][j].w); }
#pragma unroll
        for (int q = 0; q < 2; ++q) {
            const int m = m0 + q, b = m >> 12;
            const float rstd = 1.0f / sqrtf(wave_sum(s[q]) * (1.0f / D) + 1e-6f);
            const f32x4* sh = (const f32x4*)(modl + (size_t)b * 9216 + shi * 1024) + lane;
            const f32x4* sc = (const f32x4*)(modl + (size_t)b * 9216 + (shi + 1) * 1024) + lane;
            u32x2* o8 = (u32x2*)(H + (size_t)m * D) + lane;
#pragma unroll
            for (int j = 0; j < 4; ++j) { const f32x4 a = sh[64 * j], c = sc[64 * j]; const f32x4 o = v[q][j] * rstd * (c + 1.0f) + a;
                u32x2 w; w.x = pk2(o.x, o.y); w.y = pk2(o.z, o.w); o8[64 * j] = w; }
            if (copy_dst) { f32x4* cd = (f32x4*)(copy_dst + (size_t)m * D) + lane;
#pragma unroll
                for (int j = 0; j < 4; ++j) cd[64 * j] = v[q][j]; }
        }
    }
}
__device__ __forceinline__ void final_norm(const Params& P, int gw, int NGW, int lane) {
    const float* g = (const float*)kin(28);
    for (int m0 = 2 * gw; m0 < T; m0 += 2 * NGW) {
        f32x4 v[2][4]; float s[2] = {0.f, 0.f};
#pragma unroll
        for (int q = 0; q < 2; ++q) { const f32x4* xr = (const f32x4*)(kout() + (size_t)(m0 + q) * D) + lane;
#pragma unroll
            for (int j = 0; j < 4; ++j) v[q][j] = xr[64 * j]; }
#pragma unroll
        for (int q = 0; q < 2; ++q) {
#pragma unroll
            for (int j = 0; j < 4; ++j) s[q] += (v[q][j].x * v[q][j].x + v[q][j].y * v[q][j].y) + (v[q][j].z * v[q][j].z + v[q][j].w * v[q][j].w); }
#pragma unroll
        for (int q = 0; q < 2; ++q) {
            f32x4* xr = (f32x4*)(kout() + (size_t)(m0 + q) * D) + lane;
            const float rstd = 1.0f / sqrtf(wave_sum(s[q]) * (1.0f / D) + 1e-6f);
#pragma unroll
            for (int j = 0; j < 4; ++j) { const f32x4 gg = ((const f32x4*)g)[lane + 64 * j]; xr[64 * j] = v[q][j] * rstd * gg; }
        }
    }
}

constexpr int ZL = 392;
__device__ __forceinline__ void rwkv_prep(const Params& P, int l, unsigned char* lds, int tid) {
    bf16_t* zl = (bf16_t*)lds;
    float* kl = (float*)(lds + 64 * ZL * 2);
    const float* ZF = (const float*)(kws() + WS_ZF);
    float* RKV = (float*)(kws() + WS_RKV); float* DEC = (float*)(kws() + WS_DEC); float* KKA = (float*)(kws() + WS_KKA); float* KMOD = (float*)(kws() + WS_KMOD);
    float* KK = (float*)(kws() + WS_KK); float* G = (float*)(kws() + WS_G);
    const float* mu = (const float*)kin(11) + l * 1152;
    const float* w0 = (const float*)kin(12) + l * 512; const float* a0 = (const float*)kin(14) + l * 512;
    const float* k_k = (const float*)kin(17) + l * 256; const float* k_a = (const float*)kin(18) + l * 256;
    const bf16_t* WUP = (const bf16_t*)(kws() + WS_WBF + WB_LWUP); const bf16_t* AUP = (const bf16_t*)(kws() + WS_WBF + WB_LAUP); const bf16_t* GUP = (const bf16_t*)(kws() + WS_WBF + WB_LGUP);
    for (int tile = blockIdx.x; tile < T / 64; tile += gridDim.x) {
        LAUNDER_V(tid);
        const int lane = tid & 63, wid = tid >> 6, r32 = lane & 31, hi = lane >> 5, h = wid & 3, th = wid >> 2;
        const int t0 = tile * 64, s0 = t0 & (S - 1);
#pragma unroll 4
        for (int idx = tid; idx < 64 * 288; idx += 512) {
            const int row = idx / 288, c4 = idx % 288, t = t0 + row, s = s0 + row;
            const f32x4 z = *(const f32x4*)(ZF + (size_t)t * 2048 + 4 * c4);
            f32x4 pv = {0.f, 0.f, 0.f, 0.f}, nx = {0.f, 0.f, 0.f, 0.f};
            if (s > 0) pv = *(const f32x4*)(ZF + (size_t)(t - 1) * 2048 + 4 * c4);
            if (s < S - 1) nx = *(const f32x4*)(ZF + (size_t)(t + 1) * 2048 + 4 * c4);
            const f32x4 m4 = *(const f32x4*)(mu + 4 * c4);
            f32x4 v = z + m4 * ((pv + nx) * 0.5f - z);
            const int col = 4 * c4;
            if (col < 768) {
                *(f32x4*)(RKV + (size_t)t * 768 + col) = v;
                if (col >= 256 && col < 512) *(f32x4*)(kl + row * 256 + (col - 256)) = v;
            } else {
                if (col < 896) { v.x = sigmoid_f(v.x); v.y = sigmoid_f(v.y); v.z = sigmoid_f(v.z); v.w = sigmoid_f(v.w); }
                else if (col < 1024) { v.x = tanhf(v.x); v.y = tanhf(v.y); v.z = tanhf(v.z); v.w = tanhf(v.w); }
                u32x2 w; w.x = pk2(v.x, v.y); w.y = pk2(v.z, v.w);
                *(u32x2*)(zl + row * ZL + (col - 768)) = w;
            }
        }
        __syncthreads();
        const bf16_t* za = zl + (32 * th + r32) * ZL + 8 * hi;
        const int cA = h * 64 + r32;
        float kinv[16];
        const float kk_c0 = k_k[cA], kk_c1 = k_k[cA + 32];
#pragma unroll
        for (int r = 0; r < 16; ++r) { const int tok = 32 * th + crow(r, hi); const float x0 = kl[tok * 256 + cA] * kk_c0, x1 = kl[tok * 256 + cA + 32] * kk_c1;
            const float nrm = sqrtf(half_sum(x0 * x0 + x1 * x1)); kinv[r] = 1.0f / fmaxf(nrm, 1e-12f);
            const unsigned t = (unsigned)(t0 + tok); KK[t * 256 + cA] = x0 * kinv[r]; KK[t * 256 + cA + 32] = x1 * kinv[r]; __builtin_amdgcn_sched_barrier(0); }
        const float ka0 = k_a[cA], ka1 = k_a[cA + 32];
#pragma unroll 1
        for (int d = 0; d < 2; ++d) {
            int dl = d; asm volatile("" : "+s"(dl));
            int t0l = t0; asm volatile("" : "+s"(t0l));
            { f32x16 c0, c1;
#pragma unroll
              for (int i = 0; i < 16; ++i) { c0[i] = 0.f; c1[i] = 0.f; }
              const bf16_t* wt = WUP + (size_t)dl * 256 * 64;
#pragma unroll
              for (int s = 0; s < 4; ++s) { const bf16x8 a = *(const bf16x8*)(za + 128 + dl * 64 + 16 * s);
                  const bf16x8 b0 = *(const bf16x8*)(wt + (size_t)cA * 64 + 16 * s + 8 * hi), b1 = *(const bf16x8*)(wt + (size_t)(cA + 32) * 64 + 16 * s + 8 * hi);
                  c0 = MFMA32(a, b0, c0); c1 = MFMA32(a, b1, c1); }
              const float wb0 = w0[dl * 256 + cA], wb1 = w0[dl * 256 + cA + 32];
#pragma unroll
              for (int r = 0; r < 16; ++r) { const unsigned t = (unsigned)(dl * T + t0l + 32 * th + crow(r, hi));
                  DEC[t * 256 + cA] = expf(-0.6065306597126334f * sigmoid_f(wb0 + c0[r])); DEC[t * 256 + cA + 32] = expf(-0.6065306597126334f * sigmoid_f(wb1 + c1[r])); __builtin_amdgcn_sched_barrier(0); } }
            { f32x16 c0, c1;
#pragma unroll
              for (int i = 0; i < 16; ++i) { c0[i] = 0.f; c1[i] = 0.f; }
              const bf16_t* wt = AUP + (size_t)dl * 256 * 64;
#pragma unroll
              for (int s = 0; s < 4; ++s) { const bf16x8 a = *(const bf16x8*)(za + 256 + dl * 64 + 16 * s);
                  const bf16x8 b0 = *(const bf16x8*)(wt + (size_t)cA * 64 + 16 * s + 8 * hi), b1 = *(const bf16x8*)(wt + (size_t)(cA + 32) * 64 + 16 * s + 8 * hi);
                  c0 = MFMA32(a, b0, c0); c1 = MFMA32(a, b1, c1); }
              const float ab0 = a0[dl * 256 + cA], ab1 = a0[dl * 256 + cA + 32];
#pragma unroll
              for (int r = 0; r < 16; ++r) { const unsigned t = (unsigned)(dl * T + t0l + 32 * th + crow(r, hi));
                  const float ad0 = sigmoid_f(ab0 + c0[r]), ad1 = sigmoid_f(ab1 + c1[r]);
                  const int tok = 32 * th + crow(r, hi); const float kq0 = kl[tok * 256 + cA], kq1 = kl[tok * 256 + cA + 32];
                  KKA[t * 256 + cA] = -(kq0 * kk_c0 * kinv[r] * ad0); KKA[t * 256 + cA + 32] = -(kq1 * kk_c1 * kinv[r] * ad1);
                  KMOD[t * 256 + cA] = kq0 * (1.0f + (ad0 - 1.0f) * ka0); KMOD[t * 256 + cA + 32] = kq1 * (1.0f + (ad1 - 1.0f) * ka1); __builtin_amdgcn_sched_barrier(0); } }
        }
        { f32x16 c0, c1;
#pragma unroll
          for (int i = 0; i < 16; ++i) { c0[i] = 0.f; c1[i] = 0.f; }
#pragma unroll
          for (int s = 0; s < 8; ++s) { const bf16x8 a = *(const bf16x8*)(za + 16 * s);
              const bf16x8 b0 = *(const bf16x8*)(GUP + (size_t)cA * 128 + 16 * s + 8 * hi), b1 = *(const bf16x8*)(GUP + (size_t)(cA + 32) * 128 + 16 * s + 8 * hi);
              c0 = MFMA32(a, b0, c0); c1 = MFMA32(a, b1, c1); }
#pragma unroll
          for (int r = 0; r < 16; ++r) { const unsigned t = (unsigned)(t0 + 32 * th + crow(r, hi)); G[t * 256 + cA] = c0[r]; G[t * 256 + cA + 32] = c1[r]; __builtin_amdgcn_sched_barrier(0); } }
        __syncthreads();
    }
}

__device__ __forceinline__ void mla_prep(const Params& P, int l, int gw, int NGW, int lane) {
    const float* ZF = (const float*)(kws() + WS_ZF); const int* pos = (const int*)kin(2);
    bf16_t* CQN = (bf16_t*)(kws() + WS_CQN); bf16_t* CKVN = (bf16_t*)(kws() + WS_CKVN); bf16_t* KPE = (bf16_t*)(kws() + WS_KPE);
    const float* qg = (const float*)kin(22) + l * 384; const float* kg = (const float*)kin(24) + l * 256;
    for (int mm = 2 * gw; mm < T; mm += 2 * NGW) {
        float q[2][6], kv[2][4], t1[2], t2[2]; int ps[2];
#pragma unroll
        for (int u = 0; u < 2; ++u) { const float* row = ZF + (size_t)(mm + u) * 2048;
#pragma unroll
            for (int j = 0; j < 6; ++j) q[u][j] = row[1152 + lane + 64 * j];
#pragma unroll
            for (int j = 0; j < 4; ++j) kv[u][j] = row[1536 + lane + 64 * j];
            t1[u] = row[1792 + (lane & 15)]; t2[u] = row[1808 + (lane & 15)]; ps[u] = pos[mm + u]; }
#pragma unroll
        for (int u = 0; u < 2; ++u) {
            const int m = mm + u;
            float s = 0.f;
#pragma unroll
            for (int j = 0; j < 6; ++j) s += q[u][j] * q[u][j];
            float rstd = 1.0f / sqrtf(wave_sum(s) * (1.0f / 384.0f) + 1e-6f);
#pragma unroll
            for (int j = 0; j < 6; ++j) CQN[(size_t)m * 384 + lane + 64 * j] = (bf16_t)(pk2(q[u][j] * rstd * qg[lane + 64 * j], 0.f) & 0xffffu);
            s = 0.f;
#pragma unroll
            for (int j = 0; j < 4; ++j) s += kv[u][j] * kv[u][j];
            rstd = 1.0f / sqrtf(wave_sum(s) * (1.0f / 256.0f) + 1e-6f);
#pragma unroll
            for (int j = 0; j < 4; ++j) CKVN[(size_t)m * 256 + lane + 64 * j] = (bf16_t)(pk2(kv[u][j] * rstd * kg[lane + 64 * j], 0.f) & 0xffffu);
            if (lane < 16) {
                const float inv = exp2f(-(float)lane * (LOG2_1E4 / 16.0f));
                float sn, cs; sincos_rr((float)ps[u] * inv, sn, cs);
                KPE[(size_t)m * 32 + lane] = (bf16_t)(pk2(t1[u] * cs - t2[u] * sn, 0.f) & 0xffffu);
                KPE[(size_t)m * 32 + 16 + lane] = (bf16_t)(pk2(t2[u] * cs + t1[u] * sn, 0.f) & 0xffffu);
            }
        }
    }
}

constexpr int RS = 136;
__device__ __forceinline__ void ret_state(const Params& P, int l, unsigned char* lds, int tid) {
    bf16_t* Ktf = (bf16_t*)lds; bf16_t* Ktb = Ktf + 64 * RS; bf16_t* Vt = Ktb + 64 * RS;
    bf16_t* ZR = (bf16_t*)(kws() + WS_ZR); float* KVT = (float*)(kws() + WS_KVT);
    const int* pos = (const int*)kin(2); const float* lr = (const float*)kin(26) + l * 8;
    for (int u = blockIdx.x; u < 512; u += gridDim.x) {
        LAUNDER_V(tid);
        const int lane = tid & 63, wid = tid >> 6, r32 = lane & 31, hi = lane >> 5;
        const int b = u >> 7, h = (u >> 5) & 3, n = u & 31;
        const float lgf2 = -expf(lr[h]) * LOG2E, lgb2 = -expf(lr[4 + h]) * LOG2E;
        const size_t t0 = (size_t)b * S + n * 128;
        {
            const int c = tid & 127, i8 = tid >> 7;
            bf16_t* row = ZR + (t0 + c) * 1024 + h * 64;
            const u32x4 qlo = *(const u32x4*)(row + 8 * i8), qhi = *(const u32x4*)(row + 32 + 8 * i8);
            const u32x4 klo = *(const u32x4*)(row + 256 + 8 * i8), khi = *(const u32x4*)(row + 256 + 32 + 8 * i8);
            const float p = (float)pos[t0 + c];
            const float wf = exp2f(lgf2 * (float)(127 - c)), wb = exp2f(lgb2 * (float)c);
            u32x4 oql, oqh, okl, okh;
#pragma unroll
            for (int jj = 0; jj < 4; ++jj) {
                float ql[2], qh[2], kl[2], kh[2], nql[2], nqh[2], nkl[2], nkh[2];
                ql[0] = bf2f((unsigned short)(qlo[jj] & 0xffffu)); ql[1] = bf2f((unsigned short)(qlo[jj] >> 16));
                qh[0] = bf2f((unsigned short)(qhi[jj] & 0xffffu)); qh[1] = bf2f((unsigned short)(qhi[jj] >> 16));
                kl[0] = bf2f((unsigned short)(klo[jj] & 0xffffu)); kl[1] = bf2f((unsigned short)(klo[jj] >> 16));
                kh[0] = bf2f((unsigned short)(khi[jj] & 0xffffu)); kh[1] = bf2f((unsigned short)(khi[jj] >> 16));
#pragma unroll
                for (int e = 0; e < 2; ++e) {
                    const int i = 8 * i8 + 2 * jj + e;
                    const float inv = exp2f(-(float)i * (LOG2_1E4 / 32.0f));
                    float sn, cs; sincos_rr(p * inv, sn, cs);
                    nql[e] = ql[e] * cs - qh[e] * sn; nqh[e] = qh[e] * cs + ql[e] * sn;
                    nkl[e] = (kl[e] * cs - kh[e] * sn) * 0.125f; nkh[e] = (kh[e] * cs + kl[e] * sn) * 0.125f;
                    Ktf[i * RS + c] = (bf16_t)(pk2(nkl[e] * wf, 0.f) & 0xffffu); Ktf[(32 + i) * RS + c] = (bf16_t)(pk2(nkh[e] * wf, 0.f) & 0xffffu);
                    Ktb[i * RS + c] = (bf16_t)(pk2(nkl[e] * wb, 0.f) & 0xffffu); Ktb[(32 + i) * RS + c] = (bf16_t)(pk2(nkh[e] * wb, 0.f) & 0xffffu);
                }
                oql[jj] = pk2(nql[0], nql[1]); oqh[jj] = pk2(nqh[0], nqh[1]); okl[jj] = pk2(nkl[0], nkl[1]); okh[jj] = pk2(nkh[0], nkh[1]);
            }
            *(u32x4*)(row + 8 * i8) = oql; *(u32x4*)(row + 32 + 8 * i8) = oqh; *(u32x4*)(row + 256 + 8 * i8) = okl; *(u32x4*)(row + 256 + 32 + 8 * i8) = okh;
#pragma unroll
            for (int it = 0; it < 2; ++it) {
                const int idx = tid + 512 * it, key = idx & 127, e8 = (idx >> 7) * 8;
                const u32x4 v = *(const u32x4*)(ZR + (t0 + key) * 1024 + 512 + h * 64 + e8);
#pragma unroll
                for (int i = 0; i < 8; ++i) Vt[(e8 + i) * RS + key] = (bf16_t)((v[i >> 1] >> (16 * (i & 1))) & 0xffffu);
            }
        }
        __syncthreads();
        {
            const int dir = wid >> 2, eb = (wid >> 1) & 1, db = wid & 1;
            const bf16_t* Kw = dir ? Ktb : Ktf;
            f32x16 acc;
#pragma unroll
            for (int i = 0; i < 16; ++i) acc[i] = 0.f;
#pragma unroll
            for (int s = 0; s < 8; ++s) {
                const bf16x8 a = *(const bf16x8*)(Vt + (32 * eb + r32) * RS + 16 * s + 8 * hi);
                const bf16x8 bb = *(const bf16x8*)(Kw + (32 * db + r32) * RS + 16 * s + 8 * hi);
                acc = MFMA32(a, bb, acc);
            }
            float* o = KVT + ((size_t)u * 2 + dir) * 4096;
#pragma unroll
            for (int r = 0; r < 16; ++r) o[(32 * eb + crow(r, hi)) * 64 + 32 * db + r32] = acc[r];
        }
        __syncthreads();
    }
}
__device__ __forceinline__ void ret_scan(const Params& P, int l, int tid) {
    const float* KVT = (const float*)(kws() + WS_KVT); bf16_t* RT = (bf16_t*)(kws() + WS_RT);
    const float* lr = (const float*)kin(26) + l * 8;
    for (int g = blockIdx.x * 512 + tid; g < 16 * 2 * 4096; g += gridDim.x * 512) {
        const int idx = g & 4095, dir = (g >> 12) & 1, bh = g >> 13, h = bh & 3;
        const float dc = expf(-expf(lr[dir * 4 + h]) * 128.0f);
        float kv[32];
#pragma unroll
        for (int n = 0; n < 32; ++n) kv[n] = KVT[((size_t)(bh * 32 + n) * 2 + dir) * 4096 + idx];
        float R = 0.f;
        if (dir == 0) {
#pragma unroll
            for (int n = 0; n < 32; ++n) { const size_t o = ((size_t)(bh * 32 + n) * 2 + 0) * 4096 + idx; RT[o] = (bf16_t)(pk2(R, 0.f) & 0xffffu); R = R * dc + kv[n]; } }
        else {
#pragma unroll
            for (int n = 31; n >= 0; --n) { const size_t o = ((size_t)(bh * 32 + n) * 2 + 1) * 4096 + idx; RT[o] = (bf16_t)(pk2(R, 0.f) & 0xffffu); R = R * dc + kv[n]; } }
    }
}

template <int CTRL> __device__ __forceinline__ float dpp_add(float x) { const int y = __builtin_amdgcn_update_dpp(0, __float_as_int(x), CTRL, 0xf, 0xf, false); return x + __int_as_float(y); }
__device__ __forceinline__ float row16_sum(float x) { x = dpp_add<0x128>(x); x = dpp_add<0x124>(x); x = dpp_add<0x122>(x); x = dpp_add<0x121>(x); return x; }
constexpr int SC_CH = 16, SC_BUF = SC_CH * (5 * 64 + 16), SC_YP = SC_CH * 64, SC_NB = 5;
template <int DIR> __device__ __forceinline__ void rwkv_scan_dir(const Params& P, unsigned char* lds, int sb, int tid) {
    float* buf = (float*)lds;
    float* ypart = buf + SC_NB * SC_BUF + 1024;
    const float* DEC = (const float*)(kws() + WS_DEC) + (size_t)DIR * T * 256; const float* KKA = (const float*)(kws() + WS_KKA) + (size_t)DIR * T * 256;
    const float* KMOD = (const float*)(kws() + WS_KMOD) + (size_t)DIR * T * 256; const float* KK = (const float*)(kws() + WS_KK); const float* RKV = (const float*)(kws() + WS_RKV);
    float* Y = (float*)(kws() + WS_Y) + (size_t)DIR * T * 256;
    const int chain = sb >> 2, rq = sb & 3, b = (chain >> 2) & 3, h = chain & 3;
    const int cbase = h * 64;
    const size_t row0 = (size_t)b * S;
    const int wid = tid >> 6, lane = tid & 63;
    const bool loader = wid >= 4;
    const int grp = wid - 4;
    const int ltid = tid - 256;
    f32x4 lr_[20], lv;
#define SC_LOAD(ck) do { _Pragma("unroll") for (int i = 0; i < 20; ++i) { const int wi = lane + 64 * (i & 3), st = wi >> 4, q4 = wi & 15; const int s = (ck) * SC_CH + st; const size_t gr = row0 + (DIR ? (S - 1 - s) : s); \
        const float* src_ = (i >> 2) == 0 ? DEC + gr * 256 : (i >> 2) == 1 ? KK + gr * 256 : (i >> 2) == 2 ? KKA + gr * 256 : (i >> 2) == 3 ? KMOD + gr * 256 : RKV + gr * 768; \
        lr_[i] = *(const f32x4*)(src_ + cbase + 4 * q4); } \
        { const int st = lane >> 2, q4 = lane & 3; const int s = (ck) * SC_CH + st; const size_t gr = row0 + (DIR ? (S - 1 - s) : s); lv = *(const f32x4*)(RKV + gr * 768 + 512 + cbase + rq * 16 + 4 * q4); } } while (0)
#define SC_STORE(ck) do { float* B_ = buf + ((ck) % SC_NB) * SC_BUF; _Pragma("unroll") for (int i = 0; i < 20; ++i) { const int wi = lane + 64 * (i & 3), st = wi >> 4, q4 = wi & 15; \
        *(f32x4*)(B_ + st * 336 + (i >> 2) * 64 + 4 * q4) = lr_[i]; } \
        { const int st = lane >> 2, q4 = lane & 3; *(f32x4*)(B_ + st * 336 + 320 + 4 * q4) = lv; } } while (0)
#define SC_YOUT(ck) do { const float* yp_ = ypart + ((ck) & 1) * SC_YP; const int st = ltid >> 4, rw = ltid & 15; \
        const f32x4 q_ = *(const f32x4*)(yp_ + ltid * 4); const int s = (ck) * SC_CH + st; const size_t gr = row0 + (DIR ? (S - 1 - s) : s); \
        Y[gr * 256 + cbase + rq * 16 + rw] = (q_.x + q_.y) + (q_.z + q_.w); } while (0)
    constexpr int NCH = S / SC_CH;
    if (loader) { SC_LOAD(grp); if (grp == 0) { SC_STORE(0); SC_LOAD(4); } }
    __syncthreads();
    const int rowi = (wid & 3) * 4 + (lane >> 4), j = lane & 15;
    f32x2 sA = {0.f, 0.f}, sB = {0.f, 0.f};
    for (int ck = 0; ck < NCH; ++ck) {
        if (loader) {
            if (ck + 1 < NCH && ((ck + 1) & 3) == grp) { SC_STORE(ck + 1); if (ck + 5 < NCH) SC_LOAD(ck + 5); }
            if (ck > 0) SC_YOUT(ck - 1);
        } else {
            const float* rp = buf + (ck % SC_NB) * SC_BUF + 4 * j;
            const float* vp = buf + (ck % SC_NB) * SC_BUF + 320 + rowi;
            int yoff = (ck & 1) * SC_YP + rowi * 4 + (j & 3); LAUNDER_V(yoff);
            float* yp = ypart + yoff;
            f32x4 w = *(const f32x4*)(rp), kk = *(const f32x4*)(rp + 64), kka = *(const f32x4*)(rp + 128), km = *(const f32x4*)(rp + 192), r = *(const f32x4*)(rp + 256);
            float v = *vp;
            f32x4 w1 = *(const f32x4*)(rp + 336), kk1 = *(const f32x4*)(rp + 336 + 64), kka1 = *(const f32x4*)(rp + 336 + 128), km1 = *(const f32x4*)(rp + 336 + 192), r1 = *(const f32x4*)(rp + 336 + 256);
            float v1 = vp[336];
#define LO2(x) __builtin_shufflevector(x, x, 0, 1)
#define HI2(x) __builtin_shufflevector(x, x, 2, 3)
#pragma unroll 8
            for (int st = 0; st < SC_CH; ++st) {
                const float* rn = rp + (st + 2) * 336;
                const f32x4 nw = *(const f32x4*)(rn), nkk = *(const f32x4*)(rn + 64), nkka = *(const f32x4*)(rn + 128), nkm = *(const f32x4*)(rn + 192), nr = *(const f32x4*)(rn + 256);
                const float nv = vp[(st + 2) * 336];
                f32x2 q = sA * LO2(kk); q = sB * HI2(kk) + q;
                float sk = q.x + q.y;
                float yy = 0.f;
                if (DIR == 1) { f32x2 yq = sA * LO2(r); yq = sB * HI2(r) + yq; yy = yq.x + yq.y; }
                sk = row16_sum(sk);
                f32x2 tA = LO2(km) * v, tB = HI2(km) * v;
                tA = sA * LO2(w) + tA; tB = sB * HI2(w) + tB;
                sA = LO2(kka) * sk + tA; sB = HI2(kka) * sk + tB;
                if (DIR == 0) { f32x2 yq = sA * LO2(r); yq = sB * HI2(r) + yq; yy = yq.x + yq.y; }
                yy = dpp_add<0x128>(yy); yy = dpp_add<0x124>(yy);
                yp[st * 64] = yy;
                w = w1; kk = kk1; kka = kka1; km = km1; r = r1; v = v1;
                w1 = nw; kk1 = nkk; kka1 = nkka; km1 = nkm; r1 = nr; v1 = nv;
            }
#undef LO2
#undef HI2
        }
        asm volatile("s_waitcnt lgkmcnt(0)\n\ts_barrier" ::: "memory");
    }
    if (loader) SC_YOUT(NCH - 1);
    __syncthreads();
#undef SC_LOAD
#undef SC_STORE
#undef SC_YOUT
}

__device__ __forceinline__ void rwkv_post(const Params& P, int l, int gw, int NGW, int lane) {
    const float* Y = (const float*)(kws() + WS_Y); const float* RKV = (const float*)(kws() + WS_RKV); const float* G = (const float*)(kws() + WS_G);
    bf16_t* MIX = (bf16_t*)(kws() + WS_H);
    const float* r_k = (const float*)kin(19) + l * 256; const float* ln_g = (const float*)kin(20) + l * 256; const float* ln_b = (const float*)kin(21) + l * 256;
    for (int it0 = gw; it0 < T * 4; it0 += 4 * NGW) {
        float y[4], r[4], k[4], v[4], g[4], lg[4], lb[4], rk[4];
#pragma unroll
        for (int q = 0; q < 4; ++q) { const int it = it0 + q * NGW; const size_t t = (size_t)(it >> 2); const int c = (it & 3) * 64 + lane;
            y[q] = Y[t * 256 + c] + Y[((size_t)T + t) * 256 + c]; r[q] = RKV[t * 768 + c]; k[q] = RKV[t * 768 + 256 + c]; v[q] = RKV[t * 768 + 512 + c]; g[q] = G[t * 256 + c];
            lg[q] = ln_g[c]; lb[q] = ln_b[c]; rk[q] = r_k[c]; }
#pragma unroll
        for (int q = 0; q < 4; ++q) { const int it = it0 + q * NGW; const size_t t = (size_t)(it >> 2); const int c = (it & 3) * 64 + lane;
            const float mean = wave_sum(y[q]) * (1.0f / 64.0f);
            const float dd = y[q] - mean;
            const float var = wave_sum(dd * dd) * (1.0f / 64.0f);
            const float yn = dd * (1.0f / sqrtf(var + 64e-5f)) * lg[q] + lb[q];
            const float bonus = wave_sum(r[q] * k[q] * rk[q]) * v[q];
            MIX[t * 1024 + c] = (bf16_t)(pk2((yn + bonus) * g[q], 0.f) & 0xffffu); }
    }
}

constexpr int AK = 104, AV = 72;
constexpr int AT_KB = 64 * AK * 2, AT_VB = 64 * AV * 2;
__device__ __forceinline__ float max3_asm(float a, float b, float c) { float r; asm("v_max3_f32 %0, %1, %2, %3" : "=v"(r) : "v"(a), "v"(b), "v"(c)); return r; }
__device__ __forceinline__ float max2_asm(float a, float b) { float r; asm("v_max_f32_e32 %0, %1, %2" : "=v"(r) : "v"(a), "v"(b)); return r; }
__device__ __forceinline__ float halves_max(float m) { auto rr = __builtin_amdgcn_permlane32_swap(__float_as_uint(m), __float_as_uint(m), false, false); return max2_asm(__uint_as_float(rr[0]), __uint_as_float(rr[1])); }
constexpr float ATT_THR = 12.0f;
__device__ __forceinline__ void attn_unit(const Params& P, unsigned char* lds, int b, int h, int qb, int tid) {
    const int lane = tid & 63, r32 = lane & 31, hi = lane >> 5, wid = tid >> 6;
    float* wsf = (float*)(lds + 2 * AT_KB + 2 * AT_VB) + wid * 64;
    const bf16_t* QB = (const bf16_t*)(kws() + WS_QB); const bf16_t* KVB = (const bf16_t*)(kws() + WS_KVB); const bf16_t* KPE = (const bf16_t*)(kws() + WS_KPE);
    const bf16_t* VTg = (const bf16_t*)(kws() + WS_VT) + (size_t)((b * 8 + h) * 64) * 4096;
    bf16_t* MIX = (bf16_t*)(kws() + WS_H); const int* pos = (const int*)kin(2);
    const size_t row0 = (size_t)b * S;
    const int q0 = qb * 256 + wid * 32;
    bf16x8 qr[6];
    {
        const size_t qrow = row0 + q0 + r32;
        float qf[6][8];
#pragma unroll
        for (int s = 0; s < 6; ++s) { const bf16x8 raw = *(const bf16x8*)(QB + qrow * 768 + h * 96 + 16 * s + 8 * hi);
#pragma unroll
            for (int j = 0; j < 8; ++j) qf[s][j] = bf2f((unsigned short)raw[j]); }
        const float p = (float)pos[qrow];
#pragma unroll
        for (int j = 0; j < 8; ++j) { const float inv = exp2f(-(float)(8 * hi + j) * (LOG2_1E4 / 16.0f)); float sn, cs; sincos_rr(p * inv, sn, cs);
            const float t1 = qf[4][j], t2 = qf[5][j]; qf[4][j] = t1 * cs - t2 * sn; qf[5][j] = t2 * cs + t1 * sn; }
        const float C2 = 0.10206207261596577f * LOG2E;
#pragma unroll
        for (int s = 0; s < 6; ++s) { u32x4 w; w.x = pk2(qf[s][0] * C2, qf[s][1] * C2); w.y = pk2(qf[s][2] * C2, qf[s][3] * C2); w.z = pk2(qf[s][4] * C2, qf[s][5] * C2); w.w = pk2(qf[s][6] * C2, qf[s][7] * C2);
            qr[s] = __builtin_bit_cast(bf16x8, w); }
    }
    const int key0 = tid / 12, part0 = tid % 12, key1 = (512 + tid) / 12, part1 = (512 + tid) % 12;
    const int ve = tid >> 3, vpart = tid & 7;
    u32x4 kA, kB = {0u, 0u, 0u, 0u}, vR;
    const bf16_t* kp0 = part0 < 8 ? KVB + (row0 + key0) * 1024 + h * 128 + part0 * 8 : KPE + (row0 + key0) * 32 + (part0 - 8) * 8;
    const bf16_t* kp1 = part1 < 8 ? KVB + (row0 + key1) * 1024 + h * 128 + part1 * 8 : KPE + (row0 + key1) * 32 + (part1 - 8) * 8;
    const int ks0 = part0 < 8 ? 64 * 1024 : 64 * 32, ks1 = part1 < 8 ? 64 * 1024 : 64 * 32;
    const bf16_t* vp0 = VTg + (size_t)ve * 4096 + vpart * 8;
#define AT_LOADK(kt) do { kA = *(const u32x4*)(kp0 + (size_t)(kt) * ks0); if (tid < 256) kB = *(const u32x4*)(kp1 + (size_t)(kt) * ks1); } while (0)
#define AT_LOADV(kt) do { vR = *(const u32x4*)(vp0 + (kt) * 64); } while (0)
#define AT_STOREK(bi) do { bf16_t* Kw_ = (bf16_t*)(lds + (bi) * AT_KB); *(u32x4*)(Kw_ + key0 * AK + part0 * 8) = kA; if (tid < 256) *(u32x4*)(Kw_ + key1 * AK + part1 * 8) = kB; } while (0)
#define AT_STOREV(bi) do { bf16_t* Vw_ = (bf16_t*)(lds + 2 * AT_KB + (bi) * AT_VB); *(u32x4*)(Vw_ + ve * AV + vpart * 8) = vR; } while (0)
#define AT_QK(P0, P1, bi, CI) do { const bf16_t* Kt_ = (const bf16_t*)(lds + (bi) * AT_KB); P0 = CI; P1 = CI; \
        _Pragma("unroll") for (int s = 0; s < 6; ++s) { const bf16x8 a0_ = *(const bf16x8*)(Kt_ + r32 * AK + 16 * s + 8 * hi), a1_ = *(const bf16x8*)(Kt_ + (32 + r32) * AK + 16 * s + 8 * hi); \
            P0 = MFMA32(a0_, qr[s], P0); P1 = MFMA32(a1_, qr[s], P1); } } while (0)
    float mref, l_part = 0.f;
    f32x16 o0, o1, negm, sa0, sa1, sb0, sb1;
#pragma unroll
    for (int i = 0; i < 16; ++i) { o0[i] = 0.f; o1[i] = 0.f; negm[i] = 0.f; }
    AT_LOADK(0); AT_LOADV(0); AT_STOREK(0); AT_STOREV(0); AT_LOADK(1);
    __syncthreads();
    AT_QK(sa0, sa1, 0, negm);
    { float mx = fmaxf(sa0[0], sa1[0]);
#pragma unroll
      for (int i = 1; i < 16; ++i) mx = fmaxf(mx, fmaxf(sa0[i], sa1[i]));
      mx = fmaxf(mx, __shfl_xor(mx, 32));
      mref = mx;
#pragma unroll
      for (int i = 0; i < 16; ++i) { sa0[i] -= mx; sa1[i] -= mx; negm[i] = -mx; } }
    AT_STOREK(1); AT_LOADK(2); AT_LOADV(1);
    __syncthreads();
#define AT_STEP(C0, C1, N0, N1, kt) do { \
        if ((kt) + 2 < S / 64) AT_STOREK((kt) & 1); \
        if ((kt) + 1 < S / 64) AT_STOREV(((kt) + 1) & 1); \
        if ((kt) + 3 < S / 64) AT_LOADK((kt) + 3); \
        if ((kt) + 2 < S / 64) AT_LOADV((kt) + 2); \
        float mx_ = max3_asm(C0[0], C0[1], C1[0]); float my_ = max3_asm(C0[2], C0[3], C1[1]); mx_ = max3_asm(mx_, C1[2], C1[3]); \
        _Pragma("unroll") for (int i = 4; i < 16; i += 4) { mx_ = max3_asm(mx_, C0[i], C0[i + 1]); my_ = max3_asm(my_, C0[i + 2], C0[i + 3]); mx_ = max3_asm(mx_, C1[i], C1[i + 1]); my_ = max3_asm(my_, C1[i + 2], C1[i + 3]); } \
        mx_ = halves_max(max2_asm(mx_, my_)); \
        if (__builtin_expect(__any(mx_ > ATT_THR), 0)) { \
            const float dl_ = fmaxf(mx_, 0.f); mref += dl_; const float f_ = __builtin_amdgcn_exp2f(-dl_); l_part *= f_; \
            _Pragma("unroll") for (int i = 0; i < 16; ++i) { C0[i] -= dl_; C1[i] -= dl_; negm[i] = -mref; } \
            if (hi == 0) wsf[r32] = f_; \
            LDSWAIT(); \
            _Pragma("unroll") for (int r = 0; r < 16; ++r) { const float fr_ = wsf[crow(r, hi)]; o0[r] *= fr_; o1[r] *= fr_; } \
        } \
        if ((kt) + 1 < S / 64) AT_QK(N0, N1, ((kt) + 1) & 1, negm);     \
        float rs0_ = 0.f, rs1_ = 0.f, rs2_ = 0.f, rs3_ = 0.f; \
        _Pragma("unroll") for (int i = 0; i < 16; i += 4) { \
            C0[i] = __builtin_amdgcn_exp2f(C0[i]); C1[i] = __builtin_amdgcn_exp2f(C1[i]); rs0_ += C0[i] + C1[i]; \
            C0[i + 1] = __builtin_amdgcn_exp2f(C0[i + 1]); C1[i + 1] = __builtin_amdgcn_exp2f(C1[i + 1]); rs1_ += C0[i + 1] + C1[i + 1]; \
            C0[i + 2] = __builtin_amdgcn_exp2f(C0[i + 2]); C1[i + 2] = __builtin_amdgcn_exp2f(C1[i + 2]); rs2_ += C0[i + 2] + C1[i + 2]; \
            C0[i + 3] = __builtin_amdgcn_exp2f(C0[i + 3]); C1[i + 3] = __builtin_amdgcn_exp2f(C1[i + 3]); rs3_ += C0[i + 3] + C1[i + 3]; } \
        l_part += (rs0_ + rs1_) + (rs2_ + rs3_); \
        { const bf16_t* Vt_ = (const bf16_t*)(lds + 2 * AT_KB + ((kt) & 1) * AT_VB); \
          _Pragma("unroll") for (int kb = 0; kb < 2; ++kb) _Pragma("unroll") for (int hf = 0; hf < 2; ++hf) { \
            u32x4 w_; \
            if (kb == 0) { w_.x = pk2(C0[8 * hf + 0], C0[8 * hf + 1]); w_.y = pk2(C0[8 * hf + 2], C0[8 * hf + 3]); w_.z = pk2(C0[8 * hf + 4], C0[8 * hf + 5]); w_.w = pk2(C0[8 * hf + 6], C0[8 * hf + 7]); } \
            else { w_.x = pk2(C1[8 * hf + 0], C1[8 * hf + 1]); w_.y = pk2(C1[8 * hf + 2], C1[8 * hf + 3]); w_.z = pk2(C1[8 * hf + 4], C1[8 * hf + 5]); w_.w = pk2(C1[8 * hf + 6], C1[8 * hf + 7]); } \
            const bf16x8 A_ = __builtin_bit_cast(bf16x8, w_); \
            const int kofs_ = 32 * kb + 16 * hf + 8 * hi; \
            const bf16x8 B0_ = *(const bf16x8*)(Vt_ + r32 * AV + kofs_), B1_ = *(const bf16x8*)(Vt_ + (32 + r32) * AV + kofs_); \
            o0 = MFMA32(A_, B0_, o0); o1 = MFMA32(A_, B1_, o1); } } \
          \
        _Pragma("unroll") for (int g_ = 0; g_ < 12; ++g_) { __builtin_amdgcn_sched_group_barrier(0x008, 1, 0); __builtin_amdgcn_sched_group_barrier(0x100, 2, 0); __builtin_amdgcn_sched_group_barrier(0x002, 5, 0); } \
        _Pragma("unroll") for (int g_ = 0; g_ < 8; ++g_) { __builtin_amdgcn_sched_group_barrier(0x008, 1, 0); __builtin_amdgcn_sched_group_barrier(0x100, 1, 0); __builtin_amdgcn_sched_group_barrier(0x002, 4, 0); } \
        __syncthreads(); \
    } while (0)
    for (int kt = 0; kt < S / 64; kt += 2) {
        AT_STEP(sa0, sa1, sb0, sb1, kt);
        AT_STEP(sb0, sb1, sa0, sa1, kt + 1);
    }
    float l_run = l_part + __shfl_xor(l_part, 32);
    if (hi == 0) wsf[32 + r32] = l_run;
    LDSWAIT();
    int q0l = q0; LAUNDER_V(q0l);
#pragma unroll
    for (int r = 0; r < 16; ++r) {
        const float rl = 1.0f / wsf[32 + crow(r, hi)];
        bf16_t* orow = MIX + (row0 + q0l + crow(r, hi)) * 1024 + 256 + h * 64;
        orow[r32] = (bf16_t)(pk2(o0[r] * rl, 0.f) & 0xffffu); orow[32 + r32] = (bf16_t)(pk2(o1[r] * rl, 0.f) & 0xffffu);
    }
    LDSWAIT();
    __syncthreads();
#undef AT_LOADK
#undef AT_LOADV
#undef AT_STOREK
#undef AT_STOREV
#undef AT_QK
#undef AT_STEP
}

constexpr int RK = 72;
__device__ __forceinline__ void ret_out(const Params& P, int l, unsigned char* lds, int u, int tid) {
    const int lane = tid & 63, r32 = lane & 31, hi = lane >> 5, wid = tid >> 6;
    bf16_t* Kl = (bf16_t*)lds;
    bf16_t* Vt = Kl + 2 * 128 * RK;
    const bf16_t* ZR = (const bf16_t*)(kws() + WS_ZR); const bf16_t* RT = (const bf16_t*)(kws() + WS_RT); bf16_t* MIX = (bf16_t*)(kws() + WS_H);
    const float* lr = (const float*)kin(26) + l * 8; const float* gn = (const float*)kin(27) + l * 256;
    const int b = u >> 6, h = (u >> 4) & 3, np = u & 15;
    const float lgf2 = -expf(lr[h]) * LOG2E, lgb2 = -expf(lr[4 + h]) * LOG2E;
    const size_t t0 = (size_t)b * S + np * 256;
#pragma unroll
    for (int it = 0; it < 4; ++it) {
        const int idx = tid + 512 * it;
        { const int part = idx & 7, key = (idx >> 3) & 127, ck = idx >> 10;
          const u32x4 kv = *(const u32x4*)(ZR + (t0 + ck * 128 + key) * 1024 + 256 + h * 64 + part * 8);
          *(u32x4*)(Kl + (ck * 128 + key) * RK + part * 8) = kv; }
        { const int key = idx & 127, e8 = ((idx >> 7) & 7) * 8, ck = idx >> 10;
          const u32x4 v = *(const u32x4*)(ZR + (t0 + ck * 128 + key) * 1024 + 512 + h * 64 + e8);
#pragma unroll
          for (int i = 0; i < 8; ++i) Vt[(ck * 64 + e8 + i) * RS + key] = (bf16_t)((v[i >> 1] >> (16 * (i & 1))) & 0xffffu); }
    }
    __syncthreads();
    const int ck = wid >> 2, c0 = 32 * (wid & 3);
    const size_t tc = t0 + ck * 128;
    const int n = np * 2 + ck;
    bf16x8 qr[4];
#pragma unroll
    for (int s = 0; s < 4; ++s) qr[s] = *(const bf16x8*)(ZR + (tc + c0 + r32) * 1024 + h * 64 + 16 * s + 8 * hi);
    const bf16_t* Kc = Kl + ck * 128 * RK; const bf16_t* Vc = Vt + ck * 64 * RS;
    f32x16 o0, o1;
#pragma unroll
    for (int i = 0; i < 16; ++i) { o0[i] = 0.f; o1[i] = 0.f; }
    const int cq = c0 + r32;
#pragma unroll 1
    for (int kb = 0; kb < 4; ++kb) {
        f32x16 p;
#pragma unroll
        for (int i = 0; i < 16; ++i) p[i] = 0.f;
#pragma unroll
        for (int s = 0; s < 4; ++s) { const bf16x8 a = *(const bf16x8*)(Kc + (32 * kb + r32) * RK + 16 * s + 8 * hi); p = MFMA32(a, qr[s], p); }
#pragma unroll
        for (int r = 0; r < 16; ++r) { const int mkey = 32 * kb + crow(r, hi); const int df = cq - mkey;
            const float wgt = df >= 0 ? __builtin_amdgcn_exp2f(lgf2 * (float)df) : __builtin_amdgcn_exp2f(lgb2 * (float)(-df)); p[r] *= wgt; }
#pragma unroll
        for (int hf = 0; hf < 2; ++hf) {
            u32x4 w; w.x = pk2(p[8 * hf + 0], p[8 * hf + 1]); w.y = pk2(p[8 * hf + 2], p[8 * hf + 3]); w.z = pk2(p[8 * hf + 4], p[8 * hf + 5]); w.w = pk2(p[8 * hf + 6], p[8 * hf + 7]);
            const bf16x8 A = __builtin_bit_cast(bf16x8, w);
            const int kofs = 32 * kb + 16 * hf + 4 * hi;
            const s16x4 l0 = *(const s16x4*)(Vc + r32 * RS + kofs), h0 = *(const s16x4*)(Vc + r32 * RS + kofs + 8);
            const s16x4 l1 = *(const s16x4*)(Vc + (32 + r32) * RS + kofs), h1 = *(const s16x4*)(Vc + (32 + r32) * RS + kofs + 8);
            const bf16x8 B0 = __builtin_shufflevector(l0, h0, 0, 1, 2, 3, 4, 5, 6, 7), B1 = __builtin_shufflevector(l1, h1, 0, 1, 2, 3, 4, 5, 6, 7);
            o0 = MFMA32(A, B0, o0); o1 = MFMA32(A, B1, o1);
        }
    }
    const int unit = (b * 4 + h) * 32 + n;
#pragma unroll 1
    for (int dir = 0; dir < 2; ++dir) {
        const bf16_t* Rt = RT + ((size_t)unit * 2 + dir) * 4096;
        const float wq = dir == 0 ? __builtin_amdgcn_exp2f(lgf2 * (float)(cq + 1)) : __builtin_amdgcn_exp2f(lgb2 * (float)(128 - cq));
#pragma unroll
        for (int s = 0; s < 4; ++s) {
            u32x4 w;
#pragma unroll
            for (int j = 0; j < 4; ++j) w[j] = pk2(bf2f((unsigned short)qr[s][2 * j]) * wq, bf2f((unsigned short)qr[s][2 * j + 1]) * wq);
            const bf16x8 A = __builtin_bit_cast(bf16x8, w);
            const bf16x8 b0 = *(const bf16x8*)(Rt + r32 * 64 + 16 * s + 8 * hi), b1 = *(const bf16x8*)(Rt + (32 + r32) * 64 + 16 * s + 8 * hi);
            o0 = MFMA32(A, b0, o0); o1 = MFMA32(A, b1, o1);
        }
    }
    const float g0 = gn[h * 64 + r32], g1 = gn[h * 64 + 32 + r32];
    int c0f = c0; LAUNDER_V(c0f);
#pragma unroll
    for (int r = 0; r < 16; ++r) {
        const float mean = half_sum(o0[r] + o1[r]) * (1.0f / 64.0f);
        const float d0 = o0[r] - mean, d1 = o1[r] - mean;
        const float var = half_sum(d0 * d0 + d1 * d1) * (1.0f / 64.0f);
        const float rstd = 1.0f / sqrtf(var + 1e-5f);
        const size_t t = tc + c0f + crow(r, hi);
        const float ga = bf2f(ZR[t * 1024 + 768 + h * 64 + r32]), gb = bf2f(ZR[t * 1024 + 768 + h * 64 + 32 + r32]);
        const float sa = ga / (1.0f + __expf(-ga)), sb = gb / (1.0f + __expf(-gb));
        MIX[t * 1024 + 768 + h * 64 + r32] = (bf16_t)(pk2(sa * d0 * rstd * g0, 0.f) & 0xffffu);
        MIX[t * 1024 + 768 + h * 64 + 32 + r32] = (bf16_t)(pk2(sb * d1 * rstd * g1, 0.f) & 0xffffu);
    }
    __syncthreads();
}

#define LAS __attribute__((address_space(3)))
#define XB_TMO      128
#define XB_XCNT(j)  (256  + 64 * (j))
#define XB_XSUB(j)  (1280 + 64 * (j))
#define XB_XGEN(j)  (2304 + 64 * (j))
#define XB_TOP      3328
#define XB_TOPGEN   3392
#define XCD_BAR_WORDS 3456
#define XB_SPIN_CAP (1u << 18)

__device__ __forceinline__ unsigned xb_ld(unsigned* p)              { return __hip_atomic_load(p, __ATOMIC_RELAXED, __HIP_MEMORY_SCOPE_AGENT); }
__device__ __forceinline__ unsigned xb_add(unsigned* p, unsigned v) { return __hip_atomic_fetch_add(p, v, __ATOMIC_RELAXED, __HIP_MEMORY_SCOPE_AGENT); }
__device__ __forceinline__ unsigned xb_xcc_id() { return (unsigned)__builtin_amdgcn_s_getreg((3 << 11) | 20) & 0xFu; }
#define XB_SPIN(cond, bar) do { unsigned _sp = 0; while (cond) { __builtin_amdgcn_s_sleep(1); \
    if ((++_sp & 255u) == 0u) { if (xb_ld(&(bar)[XB_TMO])) break; if (_sp > XB_SPIN_CAP) { atomicAdd(&(bar)[XB_TMO], 1u); break; } } } } while (0)

struct XcdBarrier {
    unsigned* bar; unsigned x; int tid;
    volatile LAS unsigned* st;
};

__device__ __forceinline__ XcdBarrier xcd_barrier_post(unsigned* bar, volatile LAS unsigned* st) {
    XcdBarrier b; b.bar = bar; b.x = xb_xcc_id(); b.st = st;
    if (threadIdx.x == 0) (void)xb_add(&bar[XB_XCNT(b.x)], 1u);
    return b;
}
__device__ __forceinline__ void xcd_barrier_complete(unsigned* bar, unsigned x, unsigned& nloc, unsigned& nx) {
    const unsigned G = gridDim.x * gridDim.y * gridDim.z;
    unsigned sum, cnt, mine, sp = 0u;
    for (;;) {
        sum = 0u; cnt = 0u; mine = 0u;
#pragma unroll
        for (unsigned j = 0; j < 16; ++j) { const unsigned c = xb_ld(&bar[XB_XCNT(j)]); sum += c; cnt += (c > 0u) ? 1u : 0u; mine = (j == x) ? c : mine; }
        if (sum == G) break;
        __builtin_amdgcn_s_sleep(1);
        if ((++sp & 255u) == 0u) { if (xb_ld(&bar[XB_TMO])) break; if (sp > XB_SPIN_CAP) { atomicAdd(&bar[XB_TMO], 1u); break; } }
    }
    nloc = mine > 0u ? mine : 1u; nx = cnt > 0u ? cnt : 1u;
}

__device__ __forceinline__ void xcd_barrier(const XcdBarrier& b) {
    asm volatile("s_waitcnt vmcnt(0)" ::: "memory");
    __syncthreads();
    if (b.tid == 0) {
        unsigned* bar = b.bar;
        __builtin_amdgcn_s_waitcnt(0);
        unsigned nloc = b.st[0], nx = b.st[1];
        if (nloc == 0u) { xcd_barrier_complete(bar, b.x, nloc, nx); b.st[0] = nloc; b.st[1] = nx; }
        const unsigned old = xb_add(&bar[XB_XSUB(b.x)], 1u);
        const unsigned gen = old / nloc;
        if (old + 1u == (gen + 1u) * nloc) {
            __builtin_amdgcn_fence(__ATOMIC_RELEASE, "agent");
            asm volatile("s_waitcnt vmcnt(0)" ::: "memory");
            const unsigned og = xb_add(&bar[XB_TOP], 1u);
            const unsigned tg = og / nx;
            if (og + 1u == (tg + 1u) * nx) xb_add(&bar[XB_TOPGEN], 1u);
            else XB_SPIN(xb_ld(&bar[XB_TOPGEN]) == tg, bar);
            __builtin_amdgcn_fence(__ATOMIC_ACQUIRE, "agent");
            xb_add(&bar[XB_XGEN(b.x)], 1u);
            asm volatile("s_waitcnt vmcnt(0)" ::: "memory");
        } else {
            XB_SPIN(xb_ld(&bar[XB_XGEN(b.x)]) == gen, bar);
            __builtin_amdgcn_fence(__ATOMIC_ACQUIRE, "agent");
            asm volatile("s_waitcnt vmcnt(0)" ::: "memory");
        }
    }
    __syncthreads();
}

constexpr size_t WS_BAR = 819200;
__global__ void __launch_bounds__(512, 2) fwd_megakernel(Params Pdummy) {
    extern __shared__ __attribute__((aligned(16))) unsigned char lds[];
    cg::grid_group grid = cg::this_grid();
    const int G = gridDim.x, bid = blockIdx.x;
    const int wave_s = __builtin_amdgcn_readfirstlane((int)threadIdx.x >> 6);
#define HWTID() (wave_s * 64 + (int)__builtin_amdgcn_mbcnt_hi(~0u, __builtin_amdgcn_mbcnt_lo(~0u, 0u)))
    const Params& P = Pdummy;
    PG8_LAS unsigned char* ldsl = (PG8_LAS unsigned char*)lds;
    unsigned* barw = (unsigned*)(kws() + WS_BAR);
    volatile LAS unsigned* MISCp = (volatile LAS unsigned*)(ldsl + 131072 + 512);
    { int tid = threadIdx.x; LAUNDER_V(tid);
      if (bid == 0) for (int i = tid; i < XCD_BAR_WORDS; i += 512) __hip_atomic_store(barw + i, 0u, __ATOMIC_RELAXED, __HIP_MEMORY_SCOPE_AGENT);
      if (bid == 0 && tid < 64) __hip_atomic_store((unsigned*)(kws() + WS_CTR) + tid * 64, 0u, __ATOMIC_RELAXED, __HIP_MEMORY_SCOPE_AGENT);
      if (tid < 2) MISCp[tid] = 0u;
      __threadfence();
      __syncthreads();
#ifndef SKIP_MOD
      phase_mod(P, lds, tid);
#endif
    }
    grid.sync();
    (void)xcd_barrier_post(barw, MISCp);
    for (int step = 0; step < L * 14; ++step) {
        const int l = step / 14, k = step % 14;
        if (k == 7) continue;
#ifndef REPMASK
#define REPMASK 0
#endif
#ifndef SUBMASK
#define SUBMASK 0
#endif
        const int nrep = ((REPMASK >> k) & 1) ? 2 : 1;
        for (int rep = 0; rep < nrep; ++rep) {
        int tid = HWTID(); LAUNDER_V(tid);
        const int lane = tid & 63, wave = tid >> 6;
        const int vcu = (G % 8 == 0) ? (bid % 8) * (G / 8) + bid / 8 : bid;
        const int gw = vcu * 8 + wave, NGW = G * 8;
        unsigned char* ws = kws();
        const float* modl = (const float*)(ws + WS_MOD) + (size_t)l * 4 * 9216;
        pg8::Gemm g{nullptr, nullptr, 0, 0, 0}; pg8::EpiX E{0, nullptr, nullptr, nullptr, 0.f, 0}; bool do_gemm = false;
        switch (k) {
        case 0:
#ifndef SKIP_CONV
            convert_weights(P, l, lds, gw, NGW, wave, lane);
#endif
            norm_rows(P, l == 0 ? (const float*)kin(0) : kout(), l == 0 ? kout() : nullptr, l, 0, gw, NGW, lane);
            break;
        case 1:
            g = pg8::Gemm{(const bf16_t*)(ws + WS_H), (const bf16_t*)(ws + WS_WBF + WB_W1A), T, 5632, 1024}; E = pg8::EpiX{0, nullptr, (bf16_t*)(ws + WS_A), nullptr, 0.f, FF}; do_gemm = true; break;
        case 2:
            g = pg8::Gemm{(const bf16_t*)(ws + WS_A), (const bf16_t*)(ws + WS_WBF + WB_W2A), T, 1024, FF}; E = pg8::EpiX{1, kout(), nullptr, modl + 2 * 1024, 0.5f, 0}; do_gemm = true; break;
        case 3:
            norm_rows(P, kout(), nullptr, l, 3, gw, NGW, lane); break;
        case 4:
            g = pg8::Gemm{(const bf16_t*)(ws + WS_H), (const bf16_t*)(ws + WS_WBF + WB_WIN), T, 3072, 1024}; E = pg8::EpiX{2, (float*)(ws + WS_ZF), (bf16_t*)(ws + WS_ZR), nullptr, 0.f, 0}; do_gemm = true; break;
        case 5:
#ifndef SKIP_RPREP
            rwkv_prep(P, l, lds, tid);
#endif
#ifndef SKIP_MPREP
            mla_prep(P, l, gw, NGW, lane);
#endif
            __syncthreads();
#ifndef SKIP_RSTATE
            if (rep == 0) ret_state(P, l, lds, tid);
#endif
            break;
        case 6:
#ifndef SKIP_RSCAN
            ret_scan(P, l, tid);
#endif
            g = pg8::Gemm{(const bf16_t*)(ws + WS_CQN), (const bf16_t*)(ws + WS_WBF + WB_WUQ), T, 768, 384}; E = pg8::EpiX{3, nullptr, (bf16_t*)(ws + WS_QB), nullptr, 0.f, 768}; do_gemm = true; break;
        case 7:
            break;
        case 8:
#ifndef SKIP_SCAN
            for (int sr = 0; sr < ((SUBMASK & 1) ? 2 : 1); ++sr) {
            const int sbx = (((bid & 7) + 8 * ((bid >> 3) >> 2)) << 2) | ((bid >> 3) & 3);
            if (bid < 128) { if (bid >= 64) rwkv_scan_dir<1>(P, lds, sbx, tid); else rwkv_scan_dir<0>(P, lds, sbx, tid); }
            __syncthreads();
            }
#endif
            {
                unsigned* ctrl = (unsigned*)(kws() + WS_CTR) + l * 16 * 64;
                volatile unsigned* slot = (volatile unsigned*)(lds + 131072 + 1024);
                const int x0 = (int)(xb_xcc_id() & 7u);
                volatile unsigned* avail = slot + 4;
                for (;;) {
                    __syncthreads();
                    if (tid < 9) avail[tid] = __hip_atomic_load(ctrl + tid * 64, __ATOMIC_RELAXED, __HIP_MEMORY_SCOPE_AGENT);
                    __syncthreads();
                    int xs = 0;
                    for (; xs < 9; ++xs) { const int q_ = xs < 8 ? ((x0 + xs) & 7) : 8; if (avail[q_] < (xs < 8 ? 64u : 256u)) break; }
                    if (xs == 9) break;
                    const int qx = xs < 8 ? ((x0 + xs) & 7) : 8;
                    const unsigned qn = xs < 8 ? 64u : 256u;
                    for (;;) {
                        __syncthreads();
                        if (tid == 0) *slot = atomicAdd(ctrl + qx * 64, 1u);
                        __syncthreads();
                        const unsigned u = *slot;
                        if (u >= qn) break;
                        int tq = tid; LAUNDER_V(tq);
                        if (xs < 8) { const int bh = qx * 4 + (int)(u >> 4); attn_unit(P, lds, bh >> 3, bh & 7, (int)(u & 15), tq); }
                        else ret_out(P, l, lds, (int)u, tq);
                    }
                }
            }
            break;
        case 9:
#ifndef SKIP_RPOST
            rwkv_post(P, l, gw, NGW, lane);
#endif
            break;
        case 10:
            g = pg8::Gemm{(const bf16_t*)(ws + WS_H), (const bf16_t*)(ws + WS_WBF + WB_WOUT), T, 1024, 1024}; E = pg8::EpiX{1, kout(), nullptr, modl + 5 * 1024, 1.0f, 0}; do_gemm = true; break;
        case 11:
            norm_rows(P, kout(), nullptr, l, 6, gw, NGW, lane); break;
        case 12:
            g = pg8::Gemm{(const bf16_t*)(ws + WS_H), (const bf16_t*)(ws + WS_WBF + WB_W1B), T, 5632, 1024}; E = pg8::EpiX{0, nullptr, (bf16_t*)(ws + WS_A), nullptr, 0.f, FF}; do_gemm = true; break;
        default:
            g = pg8::Gemm{(const bf16_t*)(ws + WS_A), (const bf16_t*)(ws + WS_WBF + WB_W2B), T, 1024, FF}; E = pg8::EpiX{1, kout(), nullptr, modl + 8 * 1024, 0.5f, 0}; do_gemm = true; break;
        }
        if (rep > 0 && E.MODE == 1) E.coef = 0.f;
        if (do_gemm) {
            const int ngemm = (k == 6) ? 2 : 1;
            for (int gi = 0; gi < ngemm; ++gi) {
                int tg = tid; LAUNDER_V(tg);
                if (gi == 1) { g = pg8::Gemm{(const bf16_t*)(ws + WS_CKVN), (const bf16_t*)(ws + WS_WBF + WB_WUKV), T, 1024, 256}; E = pg8::EpiX{4, (float*)(ws + WS_VT), (bf16_t*)(ws + WS_KVB), nullptr, 0.f, 1024}; }
                pg8::StaticOrder So; So.init(g.M, g.N, G, bid); pg8::gemm_phase<pg8::EpiX, pg8::StaticOrder, true, true>(ldsl, g, So, E, tg);
            }
        }
        { XcdBarrier xb; xb.bar = (unsigned*)(kws() + WS_BAR); xb.x = xb_xcc_id(); xb.tid = tid; xb.st = (volatile LAS unsigned*)(ldsl + 131072 + 512); xcd_barrier(xb); }
        }
    }
    { int tid = HWTID(); LAUNDER_V(tid);
      const int lane = tid & 63, wave = tid >> 6;
      const int vcu = (G % 8 == 0) ? (bid % 8) * (G / 8) + bid / 8 : bid;
      final_norm(P, vcu * 8 + wave, G * 8, lane); }
}
}

extern "C" void kernel_launch(void* const* d_in, const int* in_sizes, int n_in, void* d_out, int out_size, void* d_ws, size_t ws_size, hipStream_t stream) {
    static int grid = 0;
    if (grid == 0) {
        if (n_in != 29 || out_size != mk::T * mk::D || ws_size < mk::WS_END) { fprintf(stderr, "kernel_launch: unexpected shapes (n_in %d, out %d, ws %zu)\n", n_in, out_size, ws_size); grid = -1; return; }
        int dev = 0, cus = 0, per_cu = 0;
        hipGetDevice(&dev);
        hipDeviceGetAttribute(&cus, hipDeviceAttributeMultiprocessorCount, dev);
        hipFuncSetAttribute((const void*)mk::fwd_megakernel, hipFuncAttributeMaxDynamicSharedMemorySize, mk::LDS_BYTES);
        hipOccupancyMaxActiveBlocksPerMultiprocessor(&per_cu, (const void*)mk::fwd_megakernel, 512, mk::LDS_BYTES);
        if (per_cu < 1) per_cu = 1;
        grid = cus * per_cu;
        (void)hipGetLastError();
    }
    if (grid < 0) return;
    mk::Params p{};
    for (int i = 0; i < 29; ++i) p.in[i] = d_in[i];
    p.out = (float*)d_out; p.ws = (unsigned char*)d_ws;
    void* args[] = {&p};
    hipError_t e = hipLaunchCooperativeKernel((const void*)mk::fwd_megakernel, dim3(grid), dim3(512), args, mk::LDS_BYTES, stream);
    if (e != hipSuccess) fprintf(stderr, "cooperative launch failed: %s (grid %d)\n", hipGetErrorString(e), grid);
}
```
